# Optimizing an MI355X kernel written in HIP

```python
import math
import jax, jax.numpy as jnp
from jax import lax
import numpy as np

D_MODEL = 1024
BATCH = 32
SEQ = 2048
DEPTH = 4

GRID_W = 64
CTX_LEN = 256
N_MIXERS = 3
N_A = (DEPTH + 2) // 3
N_B = (DEPTH + 1) // 3
N_C = DEPTH // 3
NORM_EPS = 1e-6
ROPE_BASE = 10000.0
Q_BLOCK = 128
NEG_INF = -1e30
MOD_GAIN = 0.5

A_HEADS = 8
A_Q_RANK = 512
A_KV_RANK = 256
A_NOPE = 128
A_ROPE = 64
A_VDIM = 128
A_WIDTH = A_HEADS * A_VDIM
A_IN = A_Q_RANK + A_KV_RANK + A_ROPE + A_WIDTH

B_HEADS = 16
B_KV_HEADS = 4
B_GROUP = B_HEADS // B_KV_HEADS
B_HDIM = 64
B_WINDOW = 128
B_BLOCK = 128
B_WIDTH = B_HEADS * B_HDIM
B_KVW = B_KV_HEADS * B_HDIM
B_IN = B_WIDTH + 2 * B_KVW + B_WIDTH

C_WIDTH = D_MODEL
C_ORDER = 2
C_SHORT = 3
C_BANDS = 16
C_EMB = 1 + 2 * C_BANDS
C_FFN = 64
C_TARGET = 1e-2
C_FAST = 0.3
C_SLOW = 1.5
C_MIN_DECAY = math.log(C_TARGET) / C_SLOW
C_MAX_DECAY = math.log(C_TARGET) / C_FAST
C_FILTER_GAIN = 0.1
C_IN = (C_ORDER + 1) * C_WIDTH + C_WIDTH

kernel_name = 'hybrid_mla_swa_hyena_prefix_dit'


def rmsnorm(x, g):
    xf = x.astype(jnp.float32)
    y = xf * lax.rsqrt(jnp.mean(xf * xf, axis=-1, keepdims=True) + NORM_EPS)
    return (y * g.astype(jnp.float32)).astype(x.dtype)


def axial_rope(n, rot_dim):
    rows = n // GRID_W
    row = jnp.repeat(jnp.arange(rows, dtype=jnp.float32), GRID_W)
    col = jnp.tile(jnp.arange(GRID_W, dtype=jnp.float32), rows)
    per_axis = rot_dim // 2
    inv = ROPE_BASE ** (-jnp.arange(0, per_axis, 2, dtype=jnp.float32) / per_axis)
    ang = jnp.concatenate([row[:, None] * inv, col[:, None] * inv], axis=-1)
    return jnp.cos(ang), jnp.sin(ang)


def apply_rope(x, cos, sin):
    half = x.shape[-1] // 2
    x1 = x[..., :half].astype(jnp.float32)
    x2 = x[..., half:].astype(jnp.float32)
    return jnp.concatenate([x1 * cos - x2 * sin, x1 * sin + x2 * cos], axis=-1).astype(x.dtype)


def dense_attend(q, k, v, scale):
    s = jnp.einsum('bqhd,bkhd->bhqk', q, k).astype(jnp.float32) * scale
    p = jax.nn.softmax(s, axis=-1).astype(v.dtype)
    return jnp.einsum('bhqk,bkhd->bqhd', p, v)


def blockwise_attend(q, k, v, scale):
    b, n, h, d = q.shape
    qb = q.reshape(b, n // Q_BLOCK, Q_BLOCK, h, d).swapaxes(0, 1)
    ob = lax.map(lambda qi: dense_attend(qi, k, v, scale), qb)
    return ob.swapaxes(0, 1).reshape(b, n, h, v.shape[-1])


def sink_attend(scores, values, sink_l):
    sink_col = jnp.broadcast_to(sink_l[None, :, :, None, None], scores[0].shape[:-1] + (1,))
    p = jax.nn.softmax(jnp.concatenate(scores + [sink_col], axis=-1), axis=-1)
    offset = 0
    parts = []
    for s, v in zip(scores, values):
        kk = s.shape[-1]
        parts.append(jnp.einsum('bhgqk,bkhd->bqhgd', p[..., offset:offset + kk].astype(v.dtype), v))
        offset += kk
    out = parts[0]
    for part in parts[1:]:
        out = out + part
    return out


def mla_mixer(hx, hc, w_in, g_q, w_q, g_kv, w_kv, w_out, with_ctx_out):
    b, n, _ = hx.shape
    cos, sin = axial_rope(n, A_ROPE)
    split_at = [A_Q_RANK, A_Q_RANK + A_KV_RANK, A_Q_RANK + A_KV_RANK + A_ROPE]
    scale = (A_NOPE + A_ROPE) ** -0.5

    def queries(cq, rope):
        bb, m, _ = cq.shape
        q = (rmsnorm(cq, g_q) @ w_q).reshape(bb, m, A_HEADS, A_NOPE + A_ROPE)
        if rope:
            q = jnp.concatenate([q[..., :A_NOPE], apply_rope(q[..., A_NOPE:], cos[:, None, :], sin[:, None, :])], axis=-1)
        return q

    def keys_values(ckv, kr, rope):
        bb, m, _ = ckv.shape
        kv = (rmsnorm(ckv, g_kv) @ w_kv).reshape(bb, m, A_HEADS, A_NOPE + A_VDIM)
        if rope:
            kr = apply_rope(kr, cos, sin)
        kr = jnp.broadcast_to(kr[:, :, None, :], (bb, m, A_HEADS, A_ROPE))
        return jnp.concatenate([kv[..., :A_NOPE], kr], axis=-1), kv[..., A_NOPE:]

    cq_x, ckv_x, kr_x, gate_x = jnp.split(hx @ w_in, split_at, axis=-1)
    q_x = queries(cq_x, True)
    k_x, v_x = keys_values(ckv_x, kr_x, True)
    if with_ctx_out:
        cq_c, ckv_c, kr_c, gate_c = jnp.split(hc @ w_in, split_at, axis=-1)
    else:
        ckv_c, kr_c = jnp.split(hc @ w_in[:, split_at[0]:split_at[2]], [A_KV_RANK], axis=-1)
    k_c, v_c = keys_values(ckv_c, kr_c, False)

    k_all = jnp.concatenate([k_c, k_x], axis=1)
    v_all = jnp.concatenate([v_c, v_x], axis=1)
    o_x = blockwise_attend(q_x, k_all, v_all, scale)
    y_x = (o_x.reshape(b, n, A_WIDTH) * jax.nn.silu(gate_x)) @ w_out
    if not with_ctx_out:
        return y_x, None
    q_c = queries(cq_c, False)
    o_c = dense_attend(q_c, k_c, v_c, scale)
    y_c = (o_c.reshape(b, hc.shape[1], A_WIDTH) * jax.nn.silu(gate_c)) @ w_out
    return y_x, y_c


def swa_mixer(hx, hc, w_in, sink, w_out, with_ctx_out):
    b, n, _ = hx.shape
    cos, sin = axial_rope(n, B_HDIM)
    scale = B_HDIM ** -0.5
    sink_l = sink.astype(jnp.float32).reshape(B_KV_HEADS, B_GROUP)

    def project(h):
        m = h.shape[1]
        q, k, v, gate = jnp.split(h @ w_in, [B_WIDTH, B_WIDTH + B_KVW, B_WIDTH + 2 * B_KVW], axis=-1)
        return (q.reshape(b, m, B_KV_HEADS, B_GROUP, B_HDIM), k.reshape(b, m, B_KV_HEADS, B_HDIM),
                v.reshape(b, m, B_KV_HEADS, B_HDIM), gate)

    q_x, k_x, v_x, gate_x = project(hx)
    q_c, k_c, v_c, gate_c = project(hc)
    q_x = apply_rope(q_x, cos[:, None, None, :], sin[:, None, None, :])
    k_x = apply_rope(k_x, cos[:, None, :], sin[:, None, :])

    pad = ((0, 0), (B_BLOCK, B_BLOCK), (0, 0), (0, 0))
    kp = jnp.pad(k_x, pad)
    vp = jnp.pad(v_x, pad)
    n_blocks = n // B_BLOCK
    qb = q_x.reshape(b, n_blocks, B_BLOCK, B_KV_HEADS, B_GROUP, B_HDIM).swapaxes(0, 1)

    def band_block(args):
        i, qi = args
        start = i * B_BLOCK
        kb = lax.dynamic_slice_in_dim(kp, start, 3 * B_BLOCK, axis=1)
        vb = lax.dynamic_slice_in_dim(vp, start, 3 * B_BLOCK, axis=1)
        qpos = start + jnp.arange(B_BLOCK)
        kpos = start - B_BLOCK + jnp.arange(3 * B_BLOCK)
        mask = (jnp.abs(qpos[:, None] - kpos[None, :]) <= B_WINDOW) & (kpos[None, :] >= 0) & (kpos[None, :] < n)
        s_band = jnp.einsum('bqhgd,bkhd->bhgqk', qi, kb).astype(jnp.float32) * scale
        s_band = jnp.where(mask, s_band, NEG_INF)
        s_ctx = jnp.einsum('bqhgd,bkhd->bhgqk', qi, k_c).astype(jnp.float32) * scale
        return sink_attend([s_ctx, s_band], [v_c, vb], sink_l)

    ob = lax.map(band_block, (jnp.arange(n_blocks), qb))
    o_x = ob.swapaxes(0, 1).reshape(b, n, B_WIDTH)
    y_x = (o_x * jax.nn.silu(gate_x)) @ w_out
    if not with_ctx_out:
        return y_x, None
    s_cc = jnp.einsum('bqhgd,bkhd->bhgqk', q_c, k_c).astype(jnp.float32) * scale
    o_c = sink_attend([s_cc], [v_c], sink_l).reshape(b, hc.shape[1], B_WIDTH)
    y_c = (o_c * jax.nn.silu(gate_c)) @ w_out
    return y_x, y_c


def short_conv(u, w, bias):
    n = u.shape[1]
    p = C_SHORT // 2
    up = jnp.pad(u, ((0, 0), (p, p), (0, 0)))
    y = bias
    for j in range(C_SHORT):
        y = y + up[:, j:j + n] * w[j]
    return y


def hyena_filters(n, f_w1, f_b1, f_freq, f_w2, f_b2, f_w3):
    t = jnp.linspace(0.0, 1.0, n, dtype=jnp.float32)[:, None]
    w = (2.0 * math.pi / n) * jnp.arange(n, dtype=jnp.float32)[:, None]
    bands = jnp.linspace(1e-4, C_BANDS - 1, C_BANDS, dtype=jnp.float32)[None, :]
    z = jnp.concatenate([t, jnp.cos(bands * w), -jnp.sin(bands * w)], axis=-1)
    freq = f_freq.astype(jnp.float32)
    h = jnp.sin(freq * (z @ f_w1 + f_b1))
    h = jnp.sin(freq * (h @ f_w2 + f_b2))
    h = (h @ f_w3).astype(jnp.float32).reshape(n, 2, C_ORDER, C_WIDTH)
    deltas = jnp.abs(jnp.linspace(C_MIN_DECAY, C_MAX_DECAY, C_WIDTH, dtype=jnp.float32))
    return h * jnp.exp(-t[:, :, None, None] * deltas)


def bidir_long_conv(u, h_fwd, h_bwd, bias):
    n = u.shape[1]
    lag0 = h_fwd[:1] + h_bwd[:1]
    k = jnp.concatenate([lag0, h_fwd[1:], jnp.zeros((1, C_WIDTH), jnp.float32), h_bwd[:0:-1]], axis=0)
    uf = jnp.fft.rfft(u.astype(jnp.float32), n=2 * n, axis=1)
    kf = jnp.fft.rfft(k, axis=0)
    y = jnp.fft.irfft(uf * kf[None], n=2 * n, axis=1)[:, :n]
    return (y + u.astype(jnp.float32) * bias.astype(jnp.float32)).astype(u.dtype)


def hyena_mixer(hx, hc, w_in, conv_w, conv_b, f_w1, f_b1, f_freq, f_w2, f_b2, f_w3, filt_bias, w_out, with_ctx_out):
    def run(h):
        n = h.shape[1]
        p = h @ w_in
        u = short_conv(p[..., :(C_ORDER + 1) * C_WIDTH], conv_w, conv_b)
        gate = p[..., (C_ORDER + 1) * C_WIDTH:]
        v, *gx = jnp.split(u, C_ORDER + 1, axis=-1)
        filt = hyena_filters(n, f_w1, f_b1, f_freq, f_w2, f_b2, f_w3)
        z = v
        for o in range(C_ORDER):
            z = gx[o] * bidir_long_conv(z, filt[:, 0, o], filt[:, 1, o], filt_bias[o])
        return (z * jax.nn.silu(gate)) @ w_out
    y_x = run(hx)
    y_c = run(hc) if with_ctx_out else None
    return y_x, y_c


def setup_inputs(seed: int = 0) -> dict:
    key = jax.random.key(seed)
    ks = iter(jax.random.split(key, 40))
    f32 = jnp.float32

    def nrm(shape, fan_in, gain=1.0):
        return jax.random.normal(next(ks), shape, f32) * (gain * fan_in ** -0.5)

    def gains(shape):
        return 1.0 + 0.01 * jax.random.normal(next(ks), shape, f32)

    def small(shape, s=0.01):
        return s * jax.random.normal(next(ks), shape, f32)

    D = D_MODEL
    return {
        'x': jax.random.normal(next(ks), (BATCH, SEQ, D), f32),
        'c': jax.random.normal(next(ks), (BATCH, D), f32),
        'ctx': jax.random.normal(next(ks), (BATCH, CTX_LEN, D), f32),
        'c_ctx': jax.random.normal(next(ks), (D,), f32),
        'w_mod': nrm((DEPTH, D, 3 * D), D, MOD_GAIN),
        'b_mod': small((DEPTH, 3 * D)),
        'g_pre': gains((DEPTH, D)),
        'g_post': gains((DEPTH, D)),
        'a_w_in': nrm((N_A, D, A_IN), D),
        'a_g_q': gains((N_A, A_Q_RANK)),
        'a_w_q': nrm((N_A, A_Q_RANK, A_HEADS * (A_NOPE + A_ROPE)), A_Q_RANK),
        'a_g_kv': gains((N_A, A_KV_RANK)),
        'a_w_kv': nrm((N_A, A_KV_RANK, A_HEADS * (A_NOPE + A_VDIM)), A_KV_RANK),
        'a_w_out': nrm((N_A, A_WIDTH, D), A_WIDTH),
        'b_w_in': nrm((N_B, D, B_IN), D),
        'b_sink': small((N_B, B_HEADS), 0.5),
        'b_w_out': nrm((N_B, B_WIDTH, D), B_WIDTH),
        'c_w_in': nrm((N_C, D, C_IN), D),
        'c_conv_w': nrm((N_C, C_SHORT, (C_ORDER + 1) * C_WIDTH), C_SHORT),
        'c_conv_b': small((N_C, (C_ORDER + 1) * C_WIDTH)),
        'c_f_w1': nrm((N_C, C_EMB, C_FFN), C_EMB),
        'c_f_b1': small((N_C, C_FFN), 0.1),
        'c_f_freq': gains((N_C, C_FFN)),
        'c_f_w2': nrm((N_C, C_FFN, C_FFN), C_FFN),
        'c_f_b2': small((N_C, C_FFN), 0.1),
        'c_f_w3': nrm((N_C, C_FFN, 2 * C_ORDER * C_WIDTH), C_FFN, C_FILTER_GAIN),
        'c_filt_bias': small((N_C, C_ORDER, C_WIDTH), 0.1),
        'c_w_out': nrm((N_C, C_WIDTH, D), C_WIDTH),
    }


def reference(x, c, ctx, c_ctx, w_mod, b_mod, g_pre, g_post,
              a_w_in, a_g_q, a_w_q, a_g_kv, a_w_kv, a_w_out,
              b_w_in, b_sink, b_w_out,
              c_w_in, c_conv_w, c_conv_b, c_f_w1, c_f_b1, c_f_freq, c_f_w2, c_f_b2, c_f_w3, c_filt_bias, c_w_out):
    cond_x = jax.nn.silu(c)
    cond_c = jax.nn.silu(c_ctx)
    for layer in range(DEPTH):
        kind = layer % N_MIXERS
        j = layer // N_MIXERS
        with_ctx_out = layer < DEPTH - 1
        mx = cond_x @ w_mod[layer] + b_mod[layer]
        mc = cond_c @ w_mod[layer] + b_mod[layer]
        shift_x, scale_x, gate_x = jnp.split(mx[:, None, :], 3, axis=-1)
        shift_c, scale_c, gate_c = jnp.split(mc, 3, axis=-1)
        hx = rmsnorm(x, g_pre[layer]) * (1.0 + scale_x) + shift_x
        hc = rmsnorm(ctx, g_pre[layer]) * (1.0 + scale_c) + shift_c
        if kind == 0:
            yx, yc = mla_mixer(hx, hc, a_w_in[j], a_g_q[j], a_w_q[j], a_g_kv[j], a_w_kv[j], a_w_out[j], with_ctx_out)
        elif kind == 1:
            yx, yc = swa_mixer(hx, hc, b_w_in[j], b_sink[j], b_w_out[j], with_ctx_out)
        else:
            yx, yc = hyena_mixer(hx, hc, c_w_in[j], c_conv_w[j], c_conv_b[j], c_f_w1[j], c_f_b1[j], c_f_freq[j],
                                 c_f_w2[j], c_f_b2[j], c_f_w3[j], c_filt_bias[j], c_w_out[j], with_ctx_out)
        x = x + gate_x * rmsnorm(yx, g_post[layer])
        if with_ctx_out:
            ctx = ctx + gate_c * rmsnorm(yc, g_post[layer])
    return x
```

```cpp
#include <hip/hip_runtime.h>
#include <hip/hip_cooperative_groups.h>
#include <cstdio>
#include <cmath>
namespace cg = cooperative_groups;

typedef unsigned short u16;
typedef __attribute__((ext_vector_type(8))) short bf16x8;
typedef __attribute__((ext_vector_type(16))) float f32x16;
typedef __attribute__((ext_vector_type(4))) unsigned u32x4;

#define DI __device__ __forceinline__
constexpr int NB = 32, TB = 2304, ROWS = NB * TB;
constexpr float EPS = 1e-6f;
constexpr float LOG2E = 1.4426950408889634f;
constexpr int SMEM_BYTES = 149504;
constexpr int NT = 512, NW = 8;

struct Params {
  const float *x, *c, *ctx, *c_ctx, *w_mod, *b_mod, *g_pre, *g_post;
  const float *a_w_in, *a_g_q, *a_w_q, *a_g_kv, *a_w_kv, *a_w_out;
  const float *b_w_in, *b_sink, *b_w_out;
  const float *c_w_in, *c_conv_w, *c_conv_b, *c_f_w1, *c_f_b1, *c_f_freq, *c_f_w2, *c_f_b2, *c_f_w3, *c_filt_bias, *c_w_out;
  float* out;
  u16 *aWin, *aWq, *aWkv, *aWout, *bWin, *bWout, *cWin, *cWout;
  float *mod, *cosT, *sinT, *h2, *filt, *ctxw;
  u16 *R0, *BIG;
  unsigned* bar;
};

typedef __attribute__((ext_vector_type(2))) __bf16 bf16v2;
typedef __attribute__((ext_vector_type(2))) float f32v2;
DI unsigned pack2(float a, float b) { f32v2 v = {a, b}; return __builtin_bit_cast(unsigned, __builtin_convertvector(v, bf16v2)); }
DI u16 f2bf(float x) { return (u16)(pack2(x, 0.f) & 0xffffu); }
DI float bf2f(u16 v) { return __uint_as_float(((unsigned)v) << 16); }
DI float siluf(float v) { return v * __builtin_amdgcn_rcpf(1.f + __expf(-v)); }
DI f32x16 mfma32(bf16x8 a, bf16x8 b, f32x16 c) { return __builtin_amdgcn_mfma_f32_32x32x16_bf16(a, b, c, 0, 0, 0); }
DI int get_tid() { int t = threadIdx.x; asm volatile("" : "+v"(t)); return t; }
DI f32x16 zero16() { f32x16 z; for (int i = 0; i < 16; ++i) z[i] = 0.f; return z; }


#define XB_TMO      128
#define XB_XCNT(j)  (256  + 64 * (j))
#define XB_XSUB(j)  (1280 + 64 * (j))
#define XB_XGEN(j)  (2304 + 64 * (j))
#define XB_TOP      3328
#define XB_TOPGEN   3392
#define XCD_BAR_WORDS 3456
#define XB_SPIN_CAP (1u << 20)
#define LAS __attribute__((address_space(3)))
DI unsigned xb_ld(unsigned* p)              { return __hip_atomic_load(p, __ATOMIC_RELAXED, __HIP_MEMORY_SCOPE_AGENT); }
DI unsigned xb_add(unsigned* p, unsigned v) { return __hip_atomic_fetch_add(p, v, __ATOMIC_RELAXED, __HIP_MEMORY_SCOPE_AGENT); }
DI unsigned xb_xcc_id() { return (unsigned)__builtin_amdgcn_s_getreg((3 << 11) | 20) & 0xFu; }
#define XB_SPIN(cond, bar) do { unsigned _sp = 0; while (cond) { __builtin_amdgcn_s_sleep(1); \
    if ((++_sp & 255u) == 0u) { if (xb_ld(&(bar)[XB_TMO])) break; if (_sp > XB_SPIN_CAP) { atomicAdd(&(bar)[XB_TMO], 1u); break; } } } } while (0)
struct XcdBarrier { unsigned* bar; unsigned x; volatile LAS unsigned* st; };
DI XcdBarrier xcd_barrier_post(unsigned* bar, volatile LAS unsigned* st) {
  XcdBarrier b; b.bar = bar; b.x = xb_xcc_id(); b.st = st;
  if (threadIdx.x == 0) (void)xb_add(&bar[XB_XCNT(b.x)], 1u);
  return b;
}
DI void xcd_barrier_complete(unsigned* bar, unsigned x, unsigned& nloc, unsigned& nx) {
  const unsigned G = gridDim.x * gridDim.y * gridDim.z;
  unsigned sum, cnt, mine, sp = 0u;
  for (;;) {
    sum = 0u; cnt = 0u; mine = 0u;
#pragma unroll
    for (unsigned j = 0; j < 16; ++j) { const unsigned c = xb_ld(&bar[XB_XCNT(j)]); sum += c; cnt += (c > 0u) ? 1u : 0u; mine = (j == x) ? c : mine; }
    if (sum == G) break;
    __builtin_amdgcn_s_sleep(1);
    if ((++sp & 255u) == 0u) { if (xb_ld(&bar[XB_TMO])) break; if (sp > XB_SPIN_CAP) { atomicAdd(&bar[XB_TMO], 1u); break; } }
  }
  nloc = mine > 0u ? mine : 1u; nx = cnt > 0u ? cnt : 1u;
}
DI void xcd_barrier(const XcdBarrier& b) {
  asm volatile("s_waitcnt vmcnt(0)" ::: "memory");
  __syncthreads();
  if (threadIdx.x == 0) {
    unsigned* bar = b.bar;
    __builtin_amdgcn_s_waitcnt(0);
    unsigned nloc = b.st[0], nx = b.st[1];
    if (nloc == 0u) { xcd_barrier_complete(bar, b.x, nloc, nx); b.st[0] = nloc; b.st[1] = nx; }
    const unsigned old = xb_add(&bar[XB_XSUB(b.x)], 1u);
    const unsigned gen = old / nloc;
    if (old + 1u == (gen + 1u) * nloc) {
      __builtin_amdgcn_fence(__ATOMIC_RELEASE, "agent");
      asm volatile("s_waitcnt vmcnt(0)" ::: "memory");
      const unsigned og = xb_add(&bar[XB_TOP], 1u);
      const unsigned tg = og / nx;
      if (og + 1u == (tg + 1u) * nx) xb_add(&bar[XB_TOPGEN], 1u);
      else XB_SPIN(xb_ld(&bar[XB_TOPGEN]) == tg, bar);
      __builtin_amdgcn_fence(__ATOMIC_ACQUIRE, "agent");
      xb_add(&bar[XB_XGEN(b.x)], 1u);
      asm volatile("s_waitcnt vmcnt(0)" ::: "memory");
    } else {
      XB_SPIN(xb_ld(&bar[XB_XGEN(b.x)]) == gen, bar);
      __builtin_amdgcn_fence(__ATOMIC_ACQUIRE, "agent");
      asm volatile("s_waitcnt vmcnt(0)" ::: "memory");
    }
  }
  __syncthreads();
}

DI void transpose_tile(const float* __restrict__ W, u16* __restrict__ Wt, int K, int N, const float* __restrict__ gain,
                       int tile, float* sm) {
  const int ntn = N / 64, tk = tile / ntn, tn = tile % ntn, k0 = tk * 64, n0 = tn * 64, tid = threadIdx.x;
  for (int i = 0; i < 8; ++i) {
    int kk = (tid >> 6) + 8 * i, nn = tid & 63;
    float v = W[(size_t)(k0 + kk) * N + n0 + nn];
    if (gain) v *= gain[k0 + kk];
    sm[nn * 65 + kk] = v;
  }
  __syncthreads();
  for (int i = 0; i < 8; ++i) {
    int nn = (tid >> 6) + 8 * i, kk = tid & 63;
    Wt[(size_t)(n0 + nn) * K + k0 + kk] = f2bf(sm[nn * 65 + kk]);
  }
  __syncthreads();
}

DI void mod_item(const Params& p, int it, float* sm) {
  const int tid = get_tid(), col = tid & 63, kg = tid >> 6;
  const int l = it / 48, j = (it % 48) * 64 + col;
  float* sc = sm + kg * (33 * 64);
  float acc[33];
#pragma unroll
  for (int r = 0; r < 33; ++r) acc[r] = 0.f;
  __syncthreads();
  for (int k0 = kg * 128; k0 < kg * 128 + 128; k0 += 64) {
    for (int idx = col; idx < 33 * 64; idx += 64) {
      int r = idx >> 6, kk = idx & 63;
      float cv = (r < 32) ? p.c[r * 1024 + k0 + kk] : p.c_ctx[k0 + kk];
      sc[idx] = cv / (1.f + expf(-cv));
    }
    __syncthreads();
    for (int kk = 0; kk < 64; kk += 4) {
      float w0 = p.w_mod[((size_t)l * 1024 + k0 + kk) * 3072 + j];
      float w1 = p.w_mod[((size_t)l * 1024 + k0 + kk + 1) * 3072 + j];
      float w2 = p.w_mod[((size_t)l * 1024 + k0 + kk + 2) * 3072 + j];
      float w3 = p.w_mod[((size_t)l * 1024 + k0 + kk + 3) * 3072 + j];
#pragma unroll
      for (int r = 0; r < 33; ++r) {
        float4 s4 = *(const float4*)&sc[r * 64 + kk];
        acc[r] += s4.x * w0 + s4.y * w1 + s4.z * w2 + s4.w * w3;
      }
    }
    __syncthreads();
  }
  float* red = sm;
#pragma unroll
  for (int r = 0; r < 33; ++r) red[(kg * 33 + r) * 64 + col] = acc[r];
  __syncthreads();
  const float bm = p.b_mod[l * 3072 + j];
  for (int r = kg; r < 33; r += 8) {
    float t = 0.f;
#pragma unroll
    for (int g = 0; g < 8; ++g) t += red[(g * 33 + r) * 64 + col];
    p.mod[((size_t)l * 33 + r) * 3072 + j] = t + bm;
  }
  __syncthreads();
}

DI void rope_item(const Params& p, int it) {
  int idx = it * 512 + threadIdx.x;
  int pos = idx >> 5, a = idx & 31, i = a & 15;
  float inv = powf(10000.f, -(float)(2 * i) / 32.f);
  float v = (float)((a < 16) ? (pos >> 6) : (pos & 63)) * inv;
  p.cosT[idx] = cosf(v);
  p.sinT[idx] = sinf(v);
}

DI void f1_item(const Params& p, int it) {
  const int w = threadIdx.x >> 6, j = threadIdx.x & 63;
  const int pidx = it * 8 + w;
  const int n = pidx < 2048 ? 2048 : 256, t = pidx < 2048 ? pidx : pidx - 2048;
  const float tl = (float)t / (float)(n - 1);
  const float wv = (n == 2048 ? (float)(2.0 * M_PI / 2048.0) : (float)(2.0 * M_PI / 256.0)) * (float)t;
  const float bstep = (15.f - 1e-4f) / 15.f;
  float z = 0.f;
  if (j == 0) z = tl;
  else if (j <= 16) z = cosf((1e-4f + (float)(j - 1) * bstep) * wv);
  else if (j <= 32) z = -sinf((1e-4f + (float)(j - 17) * bstep) * wv);
  const float fr = p.c_f_freq[j];
  float h1 = p.c_f_b1[j];
  for (int k = 0; k < 33; ++k) h1 += __shfl(z, k) * p.c_f_w1[k * 64 + j];
  h1 = sinf(fr * h1);
  float h2 = p.c_f_b2[j];
  for (int k = 0; k < 64; ++k) h2 += __shfl(h1, k) * p.c_f_w2[k * 64 + j];
  h2 = sinf(fr * h2);
  p.h2[pidx * 64 + j] = h2;
}

DI void f2_item(const Params& p, int it) {
  const int col = (it / 9) * 2 + (threadIdx.x >> 8), tc = it % 9, tid = threadIdx.x & 255;
  const int pidx = tc * 256 + tid;
  const int n = tc < 8 ? 2048 : 256, t = tc < 8 ? pidx : tid;
  const float4* hp = (const float4*)(p.h2 + (size_t)pidx * 64);
  float acc = 0.f;
  for (int q = 0; q < 16; ++q) {
    float4 hv = hp[q];
    acc += hv.x * p.c_f_w3[(q * 4 + 0) * 4096 + col];
    acc += hv.y * p.c_f_w3[(q * 4 + 1) * 4096 + col];
    acc += hv.z * p.c_f_w3[(q * 4 + 2) * 4096 + col];
    acc += hv.w * p.c_f_w3[(q * 4 + 3) * 4096 + col];
  }
  const int c = col & 1023;
  const float dmin = logf(0.01f) / 1.5f, dmax = logf(0.01f) / 0.3f;
  const float delta = fabsf(dmin + (float)c * ((dmax - dmin) / 1023.f));
  const float tl = (float)t / (float)(n - 1);
  float v = acc * expf(-tl * delta);
  if (tc < 8) p.filt[(size_t)col * 2048 + t] = v;
  else p.filt[(size_t)4096 * 2048 + (size_t)col * 256 + t] = v;
}

DI float wave_sum(float v) {
  for (int o = 32; o >= 1; o >>= 1) v += __shfl_xor(v, o);
  return v;
}

DI void rowwise_phase(const Params& p, int l, const u16* __restrict__ Y, float* dlat = nullptr, float* dctx = nullptr, u16* dh = nullptr) {
  const int tid0 = get_tid(); const int lane = tid0 & 63, w = tid0 >> 6;
  for (int R = blockIdx.x * NW + w; R < ROWS; R += gridDim.x * NW) {
    const int b = R / TB, i = R % TB;
    const bool isctx = i < 256;
    if (isctx && l == 4) continue;
    const int mr = isctx ? 32 : b;
    float* xres = isctx ? p.ctxw + ((size_t)b * 256 + i) * 1024 : p.out + ((size_t)b * 2048 + (i - 256)) * 1024;
    const float* xin = (l == 0) ? (isctx ? p.ctx + ((size_t)b * 256 + i) * 1024 : p.x + ((size_t)b * 2048 + (i - 256)) * 1024) : xres;
    float xv[16];
#pragma unroll
    for (int k = 0; k < 4; ++k) {
      float4 v = *(const float4*)(xin + k * 256 + lane * 4);
      xv[4 * k] = v.x; xv[4 * k + 1] = v.y; xv[4 * k + 2] = v.z; xv[4 * k + 3] = v.w;
    }
    if (l > 0) {
      float yv[16], ss = 0.f;
#pragma unroll
      for (int k = 0; k < 4; ++k) {
        uint2 v = *(const uint2*)(Y + (size_t)R * 1024 + k * 256 + lane * 4);
        yv[4 * k] = bf2f((u16)(v.x & 0xffff)); yv[4 * k + 1] = bf2f((u16)(v.x >> 16));
        yv[4 * k + 2] = bf2f((u16)(v.y & 0xffff)); yv[4 * k + 3] = bf2f((u16)(v.y >> 16));
      }
#pragma unroll
      for (int e = 0; e < 16; ++e) ss += yv[e] * yv[e];
      ss = wave_sum(ss);
      const float rinv = rsqrtf(ss * (1.f / 1024.f) + EPS);
      const float* gp = p.g_post + (l - 1) * 1024;
      const float* gt = p.mod + ((size_t)(l - 1) * 33 + mr) * 3072 + 2048;
#pragma unroll
      for (int k = 0; k < 4; ++k) {
        float4 g4 = *(const float4*)(gp + k * 256 + lane * 4);
        float4 t4 = *(const float4*)(gt + k * 256 + lane * 4);
        xv[4 * k] += t4.x * (yv[4 * k] * rinv * g4.x);
        xv[4 * k + 1] += t4.y * (yv[4 * k + 1] * rinv * g4.y);
        xv[4 * k + 2] += t4.z * (yv[4 * k + 2] * rinv * g4.z);
        xv[4 * k + 3] += t4.w * (yv[4 * k + 3] * rinv * g4.w);
      }
    }
    float* xdst = xres;
    if (dlat) xdst = isctx ? dctx + ((size_t)b * 256 + i) * 1024 : dlat + ((size_t)b * 2048 + (i - 256)) * 1024;
#pragma unroll
    for (int k = 0; k < 4; ++k) {
      float4 v; v.x = xv[4 * k]; v.y = xv[4 * k + 1]; v.z = xv[4 * k + 2]; v.w = xv[4 * k + 3];
      *(float4*)(xdst + k * 256 + lane * 4) = v;
    }
    if (l < 4) {
      float ss = 0.f;
#pragma unroll
      for (int e = 0; e < 16; ++e) ss += xv[e] * xv[e];
      ss = wave_sum(ss);
      const float rinv = rsqrtf(ss * (1.f / 1024.f) + EPS);
      const float* gp = p.g_pre + l * 1024;
      const float* md = p.mod + ((size_t)l * 33 + mr) * 3072;
#pragma unroll
      for (int k = 0; k < 4; ++k) {
        float4 g4 = *(const float4*)(gp + k * 256 + lane * 4);
        float4 sh = *(const float4*)(md + k * 256 + lane * 4);
        float4 sc = *(const float4*)(md + 1024 + k * 256 + lane * 4);
        float h0 = xv[4 * k] * rinv * g4.x * (1.f + sc.x) + sh.x;
        float h1 = xv[4 * k + 1] * rinv * g4.y * (1.f + sc.y) + sh.y;
        float h2 = xv[4 * k + 2] * rinv * g4.z * (1.f + sc.z) + sh.z;
        float h3 = xv[4 * k + 3] * rinv * g4.w * (1.f + sc.w) + sh.w;
        uint2 o; o.x = pack2(h0, h1); o.y = pack2(h2, h3);
        *(uint2*)((dh ? dh : p.R0) + (size_t)R * 1024 + k * 256 + lane * 4) = o;
      }
    }
  }
}

enum { E_PLAIN = 0, E_MLA_IN, E_MLA_Q, E_MLA_KV, E_SWA_IN, E_TRANS };
struct Epi { int mode; u16* C; int ldc; u16* C2; const float* cosT; const float* sinT; };

DI void store_plain(u16* __restrict__ C, int ldc, int row0, int col0, const f32x16 (&acc)[2][2], int r, int h) {
#pragma unroll
  for (int mi = 0; mi < 2; ++mi)
#pragma unroll
    for (int ni = 0; ni < 2; ++ni)
#pragma unroll
      for (int i = 0; i < 16; ++i) {
        int row = row0 + 32 * mi + (i & 3) + 8 * (i >> 2) + 4 * h;
        C[(size_t)row * ldc + col0 + 32 * ni + r] = f2bf(acc[mi][ni][i]);
      }
}
DI void store_trans(u16* __restrict__ T, size_t ldt, size_t colbase, size_t tokbase, const f32x16 (&acc)[2][2], int r, int h, u16* st) {
#pragma unroll
  for (int mi = 0; mi < 2; ++mi)
#pragma unroll
    for (int ni = 0; ni < 2; ++ni)
#pragma unroll
      for (int g = 0; g < 4; ++g) {
        uint2 o;
        o.x = pack2(acc[mi][ni][4 * g], acc[mi][ni][4 * g + 1]);
        o.y = pack2(acc[mi][ni][4 * g + 2], acc[mi][ni][4 * g + 3]);
        *(uint2*)&st[(32 * ni + r) * 72 + 32 * mi + 8 * g + 4 * h] = o;
      }
  const int lane = r + 32 * h;
#pragma unroll
  for (int j = 0; j < 8; ++j) {
    const int chunk = j * 64 + lane, ch = chunk >> 3, t8 = (chunk & 7) * 8;
    const u32x4 v = *(const u32x4*)&st[ch * 72 + t8];
    *(u32x4*)(T + (colbase + ch) * ldt + tokbase + t8) = v;
  }
}
DI void rope_acc(const Epi& e, int row0, f32x16 (&acc)[2][2], int r, int h) {
  const int ib = row0 % TB;
  if (ib < 256) return;
#pragma unroll
  for (int mi = 0; mi < 2; ++mi)
#pragma unroll
    for (int i = 0; i < 16; ++i) {
      int pos = ib - 256 + 32 * mi + (i & 3) + 8 * (i >> 2) + 4 * h;
      float cs = e.cosT[pos * 32 + r], sn = e.sinT[pos * 32 + r];
      float x1 = acc[mi][0][i], x2 = acc[mi][1][i];
      acc[mi][0][i] = x1 * cs - x2 * sn;
      acc[mi][1][i] = x1 * sn + x2 * cs;
      if ((i & 3) == 3) __builtin_amdgcn_sched_barrier(0);
    }
}

DI void scale_acc(f32x16 (&acc)[2][2], float sc) {
#pragma unroll
  for (int mi = 0; mi < 2; ++mi)
#pragma unroll
    for (int ni = 0; ni < 2; ++ni)
#pragma unroll
      for (int i = 0; i < 16; ++i) acc[mi][ni][i] *= sc;
}
DI void epilogue(const Epi& e, int row0, int col0, f32x16 (&acc)[2][2], int r, int h, u16* st) {
  const int b = row0 / TB, ib = row0 % TB;
  switch (e.mode) {
    case E_PLAIN: store_plain(e.C, e.ldc, row0, col0, acc, r, h); break;
    case E_MLA_IN:
      if (col0 == 768) rope_acc(e, row0, acc, r, h);
      store_plain(e.C, e.ldc, row0, col0, acc, r, h); break;
    case E_MLA_Q:
      if ((col0 % 192) == 128) rope_acc(e, row0, acc, r, h);
      scale_acc(acc, 0.07216878364870322f * LOG2E);
      store_plain(e.C, e.ldc, row0, col0, acc, r, h); break;
    case E_MLA_KV: {
      int head = col0 >> 8, within = col0 & 255;
      if (within < 128) store_plain(e.C + head * 128 + within - col0, 1024, row0, col0, acc, r, h);
      else store_trans(e.C2, TB, (size_t)(b * 8 + head) * 128 + (within - 128), ib, acc, r, h, st);
    } break;
    case E_SWA_IN:
      if (col0 < 1280) { rope_acc(e, row0, acc, r, h); if (col0 < 1024) scale_acc(acc, 0.125f * LOG2E); store_plain(e.C, e.ldc, row0, col0, acc, r, h); }
      else if (col0 < 1536) { int kvh = (col0 - 1280) >> 6; store_trans(e.C2, TB, (size_t)(b * 4 + kvh) * 64, ib, acc, r, h, st); }
      else store_plain(e.C, e.ldc, row0, col0, acc, r, h);
      break;
    case E_TRANS: store_trans(e.C, ROWS, col0, row0, acc, r, h, st); break;
  }
}

DI void gemm_tile(const u16* __restrict__ A, int lda, const u16* __restrict__ Bt, int ldb, int N, int K,
                  int tm, int tn, const Epi& e, bool rownorm, char* smem) {
  constexpr int LS = 72;
  constexpr int STAGE = 512 * LS;
  u16* S0 = (u16*)smem;
  float* rs = (float*)(S0 + 2 * STAGE);
  const int tid = get_tid(), lane = tid & 63, w = tid >> 6, r = lane & 31, h = lane >> 5;
  const int wm = w >> 2, wn = w & 3;
  const int lr = tid >> 3, lk = (tid & 7) * 8;
  const u16* ap = A + (size_t)(tm * 256 + lr) * lda + lk;
  const u16* bp = Bt + (size_t)(tn * 256 + lr) * ldb + lk;
  const size_t a64 = (size_t)64 * lda, b64 = (size_t)64 * ldb;
  __syncthreads();
  float rss = 0.f;
  f32x16 acc[2][2][2];
#pragma unroll
  for (int hf = 0; hf < 2; ++hf)
#pragma unroll
    for (int mi = 0; mi < 2; ++mi)
#pragma unroll
      for (int ni = 0; ni < 2; ++ni) acc[hf][mi][ni] = zero16();
  u32x4 ra[4], rb[4];
#pragma unroll
  for (int i = 0; i < 4; ++i) { ra[i] = *(const u32x4*)(ap + i * a64); rb[i] = *(const u32x4*)(bp + i * b64); }
  u16* wa = S0 + lr * LS + lk;
#pragma unroll
  for (int i = 0; i < 4; ++i) { *(u32x4*)(wa + i * 64 * LS) = ra[i]; *(u32x4*)(wa + 256 * LS + i * 64 * LS) = rb[i]; }
  __syncthreads();
  const int nk = K >> 6;
  {
    const int ko = min(1, nk - 1) * 64;
#pragma unroll
    for (int i = 0; i < 4; ++i) { ra[i] = *(const u32x4*)(ap + i * a64 + ko); rb[i] = *(const u32x4*)(bp + i * b64 + ko); }
  }
  const u16* as0 = S0 + (wm * 128 + r) * LS + 8 * h;
  const u16* bs0 = S0 + 256 * LS + (wn * 64 + r) * LS + 8 * h;
#pragma unroll 1
  for (int kt = 0; kt < nk; ++kt) {
    const int cur = kt & 1;
    {
      u16* wn_ = wa + (cur ^ 1) * STAGE;
#pragma unroll
      for (int i = 0; i < 4; ++i) { *(u32x4*)(wn_ + i * 64 * LS) = ra[i]; *(u32x4*)(wn_ + 256 * LS + i * 64 * LS) = rb[i]; }
      const int ko = min(kt + 2, nk - 1) * 64;
#pragma unroll
      for (int i = 0; i < 4; ++i) { ra[i] = *(const u32x4*)(ap + i * a64 + ko); rb[i] = *(const u32x4*)(bp + i * b64 + ko); }
    }
    __builtin_amdgcn_sched_barrier(0);
    const u16* as = as0 + cur * STAGE;
    const u16* bs = bs0 + cur * STAGE;
    __builtin_amdgcn_s_setprio(1);
#pragma unroll
    for (int s = 0; s < 4; ++s) {
      bf16x8 af[4], bfr[2];
#pragma unroll
      for (int q = 0; q < 4; ++q) af[q] = *(const bf16x8*)&as[q * 32 * LS + 16 * s];
#pragma unroll
      for (int ni = 0; ni < 2; ++ni) bfr[ni] = *(const bf16x8*)&bs[ni * 32 * LS + 16 * s];
#pragma unroll
      for (int q = 0; q < 4; ++q)
#pragma unroll
        for (int ni = 0; ni < 2; ++ni) acc[q >> 1][q & 1][ni] = mfma32(af[q], bfr[ni], acc[q >> 1][q & 1][ni]);
    }
    __builtin_amdgcn_s_setprio(0);
    if (rownorm) {
      const u16* rp = S0 + cur * STAGE + (tid >> 1) * LS + (tid & 1) * 32;
#pragma unroll
      for (int q4 = 0; q4 < 4; ++q4) {
        const u32x4 v = *(const u32x4*)(rp + 8 * q4);
#pragma unroll
        for (int q = 0; q < 4; ++q) {
          const float a0 = bf2f((u16)(v[q] & 0xffff)), a1 = bf2f((u16)(v[q] >> 16));
          rss += a0 * a0 + a1 * a1;
        }
      }
    }
    __builtin_amdgcn_sched_barrier(0);
    __syncthreads();
  }
  if (rownorm) {
    rss += __shfl_xor(rss, 1);
    if ((tid & 1) == 0) rs[tid >> 1] = rsqrtf(rss / (float)K + EPS);
    __syncthreads();
  }
  const int row0 = tm * 256 + wm * 128, col0 = tn * 256 + wn * 64;
  if (col0 >= N) return;
#pragma unroll
  for (int hf = 0; hf < 2; ++hf) {
    if (rownorm) {
#pragma unroll
      for (int mi = 0; mi < 2; ++mi)
#pragma unroll
        for (int i = 0; i < 16; ++i) {
          float sc = rs[wm * 128 + 64 * hf + 32 * mi + (i & 3) + 8 * (i >> 2) + 4 * h];
          acc[hf][mi][0][i] *= sc; acc[hf][mi][1][i] *= sc;
        }
    }
    epilogue(e, row0 + 64 * hf, col0, acc[hf], r, h, S0 + w * (64 * 72));
  }
}

DI void gemm_phase(const u16* A, int lda, const u16* Bt, int ldb, int N, int K, const Epi& e, bool rownorm, char* smem) {
  const int ntn = (N + 255) / 256;
  if ((gridDim.x & 7) == 0) {
    const int x = blockIdx.x & 7, slot = blockIdx.x >> 3, per = gridDim.x >> 3, nl = (ROWS / 256 / 8) * ntn;
    for (int li = slot; li < nl; li += per) gemm_tile(A, lda, Bt, ldb, N, K, (li / ntn) * 8 + x, li % ntn, e, rownorm, smem);
  } else {
    const int ntiles = (ROWS / 256) * ntn;
    for (int t = blockIdx.x; t < ntiles; t += gridDim.x) gemm_tile(A, lda, Bt, ldb, N, K, t / ntn, t % ntn, e, rownorm, smem);
  }
}

struct AttnArgs {
  const u16* Q; const u16* P; const u16* KN; const u16* VT; u16* O; const float* sink; int with_ctx;
};

DI int perm32(int r) { return (r & ~12) | ((r & 4) << 1) | ((r & 8) >> 1); }

template <int MODE>
DI void attn_unit(const AttnArgs& a, int b, int head, int qb, bool isctx, char* smem) {
  constexpr int H = MODE == 0 ? 8 : 16, DQK = MODE == 0 ? 192 : 64, DV = MODE == 0 ? 128 : 64;
  constexpr int HKV = MODE == 0 ? 8 : 4, KS = DQK + 8, VS = 72, NS = DQK / 16, NDV = DV / 32;
  constexpr int LDQ = MODE == 0 ? 1536 : 2560, LDP = MODE == 0 ? 1856 : 2560, GOFF = MODE == 0 ? 832 : 1536;
  u16* Ks = (u16*)smem;
  u16* Vts = Ks + 64 * KS;
  const int tid = get_tid(), lane = tid & 63, w = tid >> 6, r = lane & 31, h = lane >> 5;
  const int hkv = MODE == 0 ? head : (head >> 2);
  const int qi = (isctx ? 0 : 256) + qb * 256 + w * 32 + r;
  const size_t Rq = (size_t)b * TB + qi;
  const int qpos = qb * 256 + w * 32 + r;
  bf16x8 qf[NS];
  {
    const u16* qp = a.Q + Rq * LDQ + head * DQK + 8 * h;
#pragma unroll
    for (int s = 0; s < NS; ++s) qf[s] = *(const bf16x8*)(qp + 16 * s);
  }
  float m = -1e30f, l = 0.f;
  if (MODE == 1) { m = a.sink[head] * LOG2E; l = (h == 0) ? 1.f : 0.f; }
  f32x16 oacc[NDV];
#pragma unroll
  for (int d = 0; d < NDV; ++d) oacc[d] = zero16();
  int tb_lo = 0, ntiles;
  if (isctx) ntiles = 4;
  else if (MODE == 0) ntiles = 36;
  else { tb_lo = (qb == 0) ? 2 : 0; const int tb_hi = (qb == 7) ? 5 : 9; ntiles = 4 + (tb_hi - tb_lo + 1); }
  const int pr = perm32(r);
  constexpr int NKL = MODE == 0 ? 3 : 1, NVL = DV / 64;
  u32x4 kreg[NKL], vreg[NVL];
  auto tile_kb = [=](int t) -> int {
    if (MODE == 1 && t >= 4) return 256 + qb * 256 - 128 + 64 * (tb_lo + t - 4);
    return 64 * t;
  };
  const int lrow = tid >> 3, lq = tid & 7;
  const u16* kbase = MODE == 0 ? a.KN + ((size_t)b * TB + lrow) * 1024 + head * 128 + lq * 16
                               : a.P + ((size_t)b * TB + lrow) * LDP + 1024 + hkv * 64 + lq * 8;
  const u16* krbase = a.P + ((size_t)b * TB + lrow) * LDP + 768 + lq * 8;
  const int vrow = MODE == 0 ? (tid >> 2) : (tid >> 3), vq = MODE == 0 ? (tid & 3) * 16 : (tid & 7) * 8;
  const u16* vbase = a.VT + ((size_t)(b * HKV + hkv) * DV + vrow) * TB + vq;
  u16* kdst = Ks + lrow * KS + (MODE == 0 ? lq * 16 : lq * 8);
  u16* krdst = Ks + lrow * KS + 128 + lq * 8;
  u16* vdst = Vts + vrow * VS + vq;
#define ATTN_ISSUE_LOADS(T) do { \
    const int kb_ = tile_kb(T); \
    if (MODE == 0) { \
      const u16* kp_ = kbase + (size_t)kb_ * 1024; \
      const u16* rp_ = krbase + (size_t)kb_ * LDP; \
      kreg[0] = *(const u32x4*)kp_; kreg[1] = *(const u32x4*)(kp_ + 8); kreg[NKL - 1] = *(const u32x4*)rp_; \
    } else { \
      kreg[0] = *(const u32x4*)(kbase + (size_t)kb_ * LDP); \
    } \
    const u16* vp_ = vbase + kb_; \
    _Pragma("unroll") for (int i_ = 0; i_ < NVL; ++i_) vreg[i_] = *(const u32x4*)(vp_ + 8 * i_); \
  } while (0)
  constexpr int ASTAGE = 64 * KS + DV * VS;
#define ATTN_WRITE_STAGE(ST) do { \
    u16* kd_ = kdst + (ST) * ASTAGE; u16* krd_ = krdst + (ST) * ASTAGE; u16* vd_ = vdst + (ST) * ASTAGE; \
    if (MODE == 0) { *(u32x4*)kd_ = kreg[0]; *(u32x4*)(kd_ + 8) = kreg[1]; *(u32x4*)krd_ = kreg[NKL - 1]; } \
    else { *(u32x4*)kd_ = kreg[0]; } \
    _Pragma("unroll") for (int i_ = 0; i_ < NVL; ++i_) *(u32x4*)(vd_ + 8 * i_) = vreg[i_]; \
  } while (0)
  ATTN_ISSUE_LOADS(0);
  __syncthreads();
  ATTN_WRITE_STAGE(0);
  __syncthreads();
  ATTN_ISSUE_LOADS(min(1, ntiles - 1));
#pragma unroll 1
  for (int t = 0; t < ntiles; ++t) {
    const bool band = (MODE == 1 && t >= 4);
    const int kpos0 = tile_kb(t) - 256;
    const int cur = t & 1;
    ATTN_WRITE_STAGE(cur ^ 1);
    ATTN_ISSUE_LOADS(min(t + 2, ntiles - 1));
    __builtin_amdgcn_sched_barrier(0);
    bool skip = false;
    if (MODE == 1 && band) {
      int q0 = qb * 256 + w * 32;
      skip = (kpos0 + 63 < q0 - 128 || kpos0 > q0 + 31 + 128);
    }
    if (!skip) {
    const u16* Kc = Ks + cur * ASTAGE;
    const u16* Vc = Vts + cur * ASTAGE;
    f32x16 sacc[2];
    sacc[0] = zero16(); sacc[1] = zero16();
    {
      const u16* kp0 = &Kc[pr * KS + 8 * h];
      const u16* kp1 = kp0 + 32 * KS;
      bf16x8 k0 = *(const bf16x8*)kp0, k1 = *(const bf16x8*)kp1;
#pragma unroll
      for (int s = 0; s < NS; ++s) {
        bf16x8 n0 = k0, n1 = k1;
        if (s + 1 < NS) { n0 = *(const bf16x8*)(kp0 + 16 * (s + 1)); n1 = *(const bf16x8*)(kp1 + 16 * (s + 1)); }
        sacc[0] = mfma32(k0, qf[s], sacc[0]);
        sacc[1] = mfma32(k1, qf[s], sacc[1]);
        k0 = n0; k1 = n1;
      }
    }
    float mx = -1e30f;
#pragma unroll
    for (int u = 0; u < 2; ++u)
#pragma unroll
      for (int i = 0; i < 16; ++i) {
        float sv = sacc[u][i];
        if (MODE == 1 && band) {
          int kpos = kpos0 + 32 * u + (i & 7) + 8 * h + 16 * (i >> 3);
          int d = qpos - kpos;
          if (d > 128 || d < -128) sv = -1e30f;
          sacc[u][i] = sv;
        }
        mx = fmaxf(mx, sv);
      }
    mx = fmaxf(mx, __shfl_xor(mx, 32));
    if (__builtin_amdgcn_ballot_w64(mx > m + 8.f) != 0ull) {
      const float mnew = fmaxf(m, mx);
      const float alpha = __builtin_amdgcn_exp2f(m - mnew);
      m = mnew;
      l *= alpha;
#pragma unroll
      for (int d = 0; d < NDV; ++d)
#pragma unroll
        for (int i = 0; i < 16; ++i) oacc[d][i] *= alpha;
    }
    float ls = 0.f;
#pragma unroll
    for (int u = 0; u < 2; ++u)
#pragma unroll
      for (int i = 0; i < 16; ++i) { float pv = __builtin_amdgcn_exp2f(sacc[u][i] - m); sacc[u][i] = pv; ls += pv; }
    l += ls;
    bf16x8 pf[2][2];
#pragma unroll
    for (int u = 0; u < 2; ++u)
#pragma unroll
      for (int s2 = 0; s2 < 2; ++s2) {
        u32x4 t4;
        t4[0] = pack2(sacc[u][8 * s2 + 0], sacc[u][8 * s2 + 1]); t4[1] = pack2(sacc[u][8 * s2 + 2], sacc[u][8 * s2 + 3]);
        t4[2] = pack2(sacc[u][8 * s2 + 4], sacc[u][8 * s2 + 5]); t4[3] = pack2(sacc[u][8 * s2 + 6], sacc[u][8 * s2 + 7]);
        pf[u][s2] = __builtin_bit_cast(bf16x8, t4);
      }
#pragma unroll
    for (int u = 0; u < 2; ++u)
#pragma unroll
      for (int s2 = 0; s2 < 2; ++s2) {
        bf16x8 vf[NDV];
#pragma unroll
        for (int d = 0; d < NDV; ++d) vf[d] = *(const bf16x8*)&Vc[(d * 32 + r) * VS + 32 * u + 16 * s2 + 8 * h];
#pragma unroll
        for (int d = 0; d < NDV; ++d) oacc[d] = mfma32(vf[d], pf[u][s2], oacc[d]);
      }
    }
    __syncthreads();
  }
  l += __shfl_xor(l, 32);
  const float linv = 1.f / l;
  {
    constexpr int SW = DV + 8;
    u16* st = (u16*)smem + w * (32 * SW);
#pragma unroll
    for (int d = 0; d < NDV; ++d)
#pragma unroll
      for (int g = 0; g < 4; ++g) {
        uint2 o;
        o.x = pack2(oacc[d][4 * g] * linv, oacc[d][4 * g + 1] * linv);
        o.y = pack2(oacc[d][4 * g + 2] * linv, oacc[d][4 * g + 3] * linv);
        *(uint2*)&st[r * SW + d * 32 + 8 * g + 4 * h] = o;
      }
    const size_t Rw = (size_t)b * TB + (isctx ? 0 : 256) + qb * 256 + w * 32;
#pragma unroll
    for (int j = 0; j < DV / 16; ++j) {
      const int chunk = j * 64 + lane, qq = chunk / (DV / 8), c8 = (chunk % (DV / 8)) * 8;
      const u32x4 ov = *(const u32x4*)&st[qq * SW + c8];
      const u32x4 gv = *(const u32x4*)(a.P + (Rw + qq) * LDP + GOFF + head * DV + c8);
      u32x4 rv;
#pragma unroll
      for (int q = 0; q < 4; ++q) {
        const float o0 = bf2f((u16)(ov[q] & 0xffff)), o1 = bf2f((u16)(ov[q] >> 16));
        const float g0 = bf2f((u16)(gv[q] & 0xffff)), g1 = bf2f((u16)(gv[q] >> 16));
        rv[q] = pack2(o0 * siluf(g0), o1 * siluf(g1));
      }
      *(u32x4*)(a.O + (Rw + qq) * 1024 + head * DV + c8) = rv;
    }
  }
}

template <int MODE>
DI void attn_phase(const AttnArgs& a, char* smem) {
  constexpr int H = MODE == 0 ? 8 : 16;
  const int NL = NB * H * 8;
  if (gridDim.x == 256) {
    const int x = blockIdx.x & 7, slot = blockIdx.x >> 3;
    const int grp = slot >> 3, qb = slot & 7;
    if (MODE == 0) {
      for (int it = 0; it < 8; ++it) { const int pair = (it * 4 + grp) * 8 + x; attn_unit<MODE>(a, pair >> 3, pair & 7, qb, false, smem); }
    } else {
      for (int it = 0; it < 16; ++it) { const int pair = it * 8 + x; attn_unit<MODE>(a, pair >> 2, (pair & 3) * 4 + grp, qb, false, smem); }
    }
  } else {
    for (int u = blockIdx.x; u < NL; u += gridDim.x) attn_unit<MODE>(a, u / (H * 8), (u >> 3) % H, u & 7, false, smem);
  }
  if (a.with_ctx) {
    const int NC = NB * H;
    for (int u = blockIdx.x; u < NC; u += gridDim.x) attn_unit<MODE>(a, u / H, u % H, 0, true, smem);
  }
}

DI void shortconv_phase(const Params& p, u16* PT) {
  const int tid0 = get_tid(); const int lane = tid0 & 63, w = tid0 >> 6;
  const int nitems = 3072 * NB * 2;
  for (int it = blockIdx.x * NW + w; it < nitems; it += gridDim.x * NW) {
    const int ch = it / (NB * 2), rem = it % (NB * 2), b = rem >> 1, isctx = rem & 1;
    const float w0 = p.c_conv_w[ch], w1 = p.c_conv_w[3072 + ch], w2 = p.c_conv_w[6144 + ch], cb = p.c_conv_b[ch];
    u16* base = PT + (size_t)ch * ROWS + (size_t)b * TB + (isctx ? 0 : 256);
    if (!isctx) {
      u32x4 q[4];
#pragma unroll
      for (int k = 0; k < 4; ++k) q[k] = *(const u32x4*)(base + (k * 64 + lane) * 8);
      float first[4], last[4];
#pragma unroll
      for (int k = 0; k < 4; ++k) { first[k] = bf2f((u16)(q[k][0] & 0xffff)); last[k] = bf2f((u16)(q[k][3] >> 16)); }
#pragma unroll
      for (int k = 0; k < 4; ++k) {
        float v[10];
#pragma unroll
        for (int e = 0; e < 4; ++e) { v[1 + 2 * e] = bf2f((u16)(q[k][e] & 0xffff)); v[2 + 2 * e] = bf2f((u16)(q[k][e] >> 16)); }
        const float lsame = __shfl_up(last[k], 1), rsame = __shfl_down(first[k], 1);
        const float lprev = (k > 0) ? __shfl(last[k > 0 ? k - 1 : 0], 63) : 0.f;
        const float rnext = (k < 3) ? __shfl(first[k < 3 ? k + 1 : 3], 0) : 0.f;
        v[0] = lane == 0 ? lprev : lsame;
        v[9] = lane == 63 ? rnext : rsame;
        u32x4 o;
#pragma unroll
        for (int e = 0; e < 4; ++e) {
          const int s2 = 2 * e;
          const float y0 = cb + w0 * v[s2] + w1 * v[s2 + 1] + w2 * v[s2 + 2];
          const float y1 = cb + w0 * v[s2 + 1] + w1 * v[s2 + 2] + w2 * v[s2 + 3];
          o[e] = pack2(y0, y1);
        }
        *(u32x4*)(base + (k * 64 + lane) * 8) = o;
      }
    } else {
      float v[6];
      uint2 q = *(const uint2*)(base + lane * 4);
      v[1] = bf2f((u16)(q.x & 0xffff)); v[2] = bf2f((u16)(q.x >> 16)); v[3] = bf2f((u16)(q.y & 0xffff)); v[4] = bf2f((u16)(q.y >> 16));
      float lft = __shfl_up(v[4], 1), rgt = __shfl_down(v[1], 1);
      v[0] = lane == 0 ? 0.f : lft;
      v[5] = lane == 63 ? 0.f : rgt;
      uint2 o;
      o.x = pack2(cb + w0 * v[0] + w1 * v[1] + w2 * v[2], cb + w0 * v[1] + w1 * v[2] + w2 * v[3]);
      o.y = pack2(cb + w0 * v[2] + w1 * v[3] + w2 * v[4], cb + w0 * v[3] + w1 * v[4] + w2 * v[5]);
      *(uint2*)(base + lane * 4) = o;
    }
  }
}

template <int MT>
DI void conv_unit(const u16* __restrict__ usrc, const u16* __restrict__ gsrc, const u16* __restrict__ gatesrc,
                  u16* __restrict__ dst, const float* __restrict__ hf, const float* __restrict__ hb, float bias,
                  int n, int tok0, int t_lo, char* smem) {
  constexpr int MROWS = MT * 256;
  const int FL = n + MROWS, FLP = FL + 16;
  const int OFF = t_lo + MROWS;
  u16* fc = (u16*)smem;
  u16* Us = fc + 8 * 3088;
  const int tid = get_tid(), lane = tid & 63, w = tid >> 6, r = lane & 31, h = lane >> 5;
  __syncthreads();
  {
    const int FL8 = FL >> 3;
    for (int idx = tid; idx < 8 * FL8; idx += NT) {
      const int sg = idx / FL8, p8 = (idx - sg * FL8) * 8;
      const int lag0 = sg + OFF - p8;
      float v[8];
#pragma unroll
      for (int j = 0; j < 8; ++j) {
        const int lag = lag0 - j;
        float x = 0.f;
        if (lag > 0) { if (lag < n) x = hf[lag]; }
        else if (lag < 0) { if (lag > -n) x = hb[-lag]; }
        else x = hf[0] + hb[0];
        v[j] = x;
      }
      u32x4 o; o[0] = pack2(v[0], v[1]); o[1] = pack2(v[2], v[3]); o[2] = pack2(v[4], v[5]); o[3] = pack2(v[6], v[7]);
      *(u32x4*)&fc[sg * FLP + p8] = o;
    }
  }
  f32x16 acc[MT];
#pragma unroll
  for (int mi = 0; mi < MT; ++mi) acc[mi] = zero16();
  const int nchunks = n / 256;
  const int abase = (r & 7) * FLP + 8 * h - 8 * (r >> 3) + OFF;
  const int ub = tid >> 4, usc = (tid & 15) * 16;
  const u16* up = usrc + (size_t)ub * TB + tok0 + usc;
  u16* ud = Us + ub * 264 + usc;
  u32x4 ureg[2];
#pragma unroll
  for (int i = 0; i < 2; ++i) ureg[i] = *(const u32x4*)(up + 8 * i);
  constexpr int USTAGE = 32 * 264;
  __syncthreads();
#pragma unroll
  for (int i = 0; i < 2; ++i) *(u32x4*)(ud + 8 * i) = ureg[i];
  __syncthreads();
  {
    const int nc = min(1, nchunks - 1);
#pragma unroll
    for (int i = 0; i < 2; ++i) ureg[i] = *(const u32x4*)(up + nc * 256 + 8 * i);
  }
#pragma unroll 1
  for (int ch = 0; ch < nchunks; ++ch) {
    const int cur = ch & 1;
#pragma unroll
    for (int i = 0; i < 2; ++i) *(u32x4*)(ud + (cur ^ 1) * USTAGE + 8 * i) = ureg[i];
    {
      const int nc = min(ch + 2, nchunks - 1);
#pragma unroll
      for (int i = 0; i < 2; ++i) ureg[i] = *(const u32x4*)(up + nc * 256 + 8 * i);
    }
    __builtin_amdgcn_sched_barrier(0);
    {
      const u16* bp_ = &Us[cur * USTAGE + r * 264 + 8 * h];
      const u16* ap_ = &fc[abase + ch * 256 - t_lo - w * MT * 32];
      bf16x8 bcur = *(const bf16x8*)bp_, acur[MT];
#pragma unroll
      for (int mi = 0; mi < MT; ++mi) acur[mi] = *(const bf16x8*)(ap_ - mi * 32);
#pragma unroll 4
      for (int kbl = 0; kbl < 16; ++kbl) {
        const int kn = min(kbl + 1, 15);
        bf16x8 bnxt = *(const bf16x8*)(bp_ + 16 * kn), anxt[MT];
#pragma unroll
        for (int mi = 0; mi < MT; ++mi) anxt[mi] = *(const bf16x8*)(ap_ + 16 * kn - mi * 32);
#pragma unroll
        for (int mi = 0; mi < MT; ++mi) acc[mi] = mfma32(acur[mi], bcur, acc[mi]);
        bcur = bnxt;
#pragma unroll
        for (int mi = 0; mi < MT; ++mi) acur[mi] = anxt[mi];
      }
    }
    __builtin_amdgcn_sched_barrier(0);
    __syncthreads();
  }
  {
    constexpr int SW = MT * 32 + 8;
    u16* st = (u16*)smem + w * (32 * SW);
#pragma unroll
    for (int mi = 0; mi < MT; ++mi)
#pragma unroll
      for (int g = 0; g < 4; ++g) {
        uint2 o;
        o.x = pack2(acc[mi][4 * g], acc[mi][4 * g + 1]);
        o.y = pack2(acc[mi][4 * g + 2], acc[mi][4 * g + 3]);
        *(uint2*)&st[r * SW + mi * 32 + 8 * g + 4 * h] = o;
      }
    const int tw = t_lo + w * MT * 32;
#pragma unroll
    for (int j = 0; j < MT * 2; ++j) {
      const int chunk = j * 64 + lane, bb = chunk / (MT * 4), t8 = (chunk % (MT * 4)) * 8;
      const u32x4 yv = *(const u32x4*)&st[bb * SW + t8];
      const size_t off = (size_t)bb * TB + tok0 + tw + t8;
      const u32x4 uv = *(const u32x4*)(usrc + off), gv = *(const u32x4*)(gsrc + off);
      u32x4 tv = uv;
      if (gatesrc) tv = *(const u32x4*)(gatesrc + off);
      u32x4 ov;
#pragma unroll
      for (int q = 0; q < 4; ++q) {
        const float y0 = bf2f((u16)(yv[q] & 0xffff)), y1 = bf2f((u16)(yv[q] >> 16));
        const float u0 = bf2f((u16)(uv[q] & 0xffff)), u1 = bf2f((u16)(uv[q] >> 16));
        const float g0 = bf2f((u16)(gv[q] & 0xffff)), g1 = bf2f((u16)(gv[q] >> 16));
        float z0 = g0 * (y0 + u0 * bias), z1 = g1 * (y1 + u1 * bias);
        if (gatesrc) { z0 *= siluf(bf2f((u16)(tv[q] & 0xffff))); z1 *= siluf(bf2f((u16)(tv[q] >> 16))); }
        ov[q] = pack2(z0, z1);
      }
      *(u32x4*)(dst + off) = ov;
    }
  }
}

DI void conv_phase(const Params& p, int o, const u16* PT, const u16* Uin, u16* dstT, char* smem) {
  const int nunits = 2048 + 1024;
  for (int u0 = blockIdx.x; u0 < nunits; u0 += gridDim.x) {
    int u = u0;
    if ((gridDim.x & 7) == 0 && u0 < 2048) {
      const int x = u0 & 7, li = u0 >> 3;
      u = (((li >> 1) * 8 + x) << 1) | (li & 1);
    }
    const bool isctx = u >= 2048;
    const int c = isctx ? (u - 2048) : (u >> 1);
    const u16* usrc = Uin + (size_t)c * ROWS;
    const u16* gsrc = PT + (size_t)(1024 * (1 + o) + c) * ROWS;
    const u16* gatesrc = o == 1 ? PT + (size_t)(3072 + c) * ROWS : nullptr;
    u16* dst = dstT + (size_t)c * ROWS;
    const float bias = p.c_filt_bias[o * 1024 + c];
    if (!isctx) {
      const float* hf = p.filt + (size_t)((0 * 2 + o) * 1024 + c) * 2048;
      const float* hb = p.filt + (size_t)((1 * 2 + o) * 1024 + c) * 2048;
      conv_unit<4>(usrc, gsrc, gatesrc, dst, hf, hb, bias, 2048, 256, (u & 1) * 1024, smem);
    } else {
      const float* fb = p.filt + (size_t)4096 * 2048;
      const float* hf = fb + (size_t)((0 * 2 + o) * 1024 + c) * 256;
      const float* hb = fb + (size_t)((1 * 2 + o) * 1024 + c) * 256;
      conv_unit<1>(usrc, gsrc, gatesrc, dst, hf, hb, bias, 256, 0, 0, smem);
    }
  }
}

DI void transpose_phase(const u16* __restrict__ src, u16* __restrict__ dst, char* smem) {
  u16* tl = (u16*)smem;
  const int tid = get_tid();
  const int ntiles = 16 * (ROWS / 64);
  for (int t = blockIdx.x; t < ntiles; t += gridDim.x) {
    const int tc = t & 15, tr = t >> 4, c0 = tc * 64, r0 = tr * 64;
    __syncthreads();
    {
      int cidx = tid, cl = cidx >> 3, q = (cidx & 7) * 8;
      uint4 v = *(const uint4*)(src + (size_t)(c0 + cl) * ROWS + r0 + q);
      unsigned* d = (unsigned*)&tl[cl * 66 + q];
      d[0] = v.x; d[1] = v.y; d[2] = v.z; d[3] = v.w;
    }
    __syncthreads();
    {
      int cidx = tid, tk = cidx >> 3, q = (cidx & 7) * 8;
      unsigned o[4];
#pragma unroll
      for (int e = 0; e < 4; ++e) o[e] = (unsigned)tl[(q + 2 * e) * 66 + tk] | ((unsigned)tl[(q + 2 * e + 1) * 66 + tk] << 16);
      uint4 v; v.x = o[0]; v.y = o[1]; v.z = o[2]; v.w = o[3];
      *(uint4*)(dst + (size_t)(r0 + tk) * 1024 + c0 + q) = v;
    }
  }
}

DI void mla_layer(const Params& p, const XcdBarrier& xb, int j, bool with_ctx, char* smem) {
  u16* P = p.BIG;
  u16* Q = P + (size_t)ROWS * 1856;
  u16* KN = Q + (size_t)ROWS * 1536;
  u16* VT = KN + (size_t)ROWS * 1024;
  Epi e{}; e.cosT = p.cosT; e.sinT = p.sinT;
  e.mode = E_MLA_IN; e.C = P; e.ldc = 1856;
  gemm_phase(p.R0, 1024, p.aWin + (size_t)j * 1856 * 1024, 1024, 1856, 1024, e, false, smem);
  xcd_barrier(xb);
  e.mode = E_MLA_Q; e.C = Q; e.ldc = 1536;
  gemm_phase(P, 1856, p.aWq + (size_t)j * 1536 * 512, 512, 1536, 512, e, true, smem);
  e.mode = E_MLA_KV; e.C = KN; e.ldc = 1024; e.C2 = VT;
  gemm_phase(P + 512, 1856, p.aWkv + (size_t)j * 2048 * 256, 256, 2048, 256, e, true, smem);
  xcd_barrier(xb);
  AttnArgs a{}; a.Q = Q; a.P = P; a.KN = KN; a.VT = VT; a.O = p.R0; a.sink = nullptr; a.with_ctx = with_ctx ? 1 : 0;
  attn_phase<0>(a, smem);
  xcd_barrier(xb);
  e.mode = E_PLAIN; e.C = Q; e.ldc = 1024;
  gemm_phase(p.R0, 1024, p.aWout + (size_t)j * 1024 * 1024, 1024, 1024, 1024, e, false, smem);
  xcd_barrier(xb);
}

__global__ void __launch_bounds__(512, 2) mega(Params p) {
  extern __shared__ __attribute__((aligned(16))) char smem[];
  __shared__ uint4 xb_words;
  if (threadIdx.x == 0) xb_words = make_uint4(0u, 0u, 0u, 0u);
  __syncthreads();
  const XcdBarrier xb = xcd_barrier_post(p.bar, (volatile LAS unsigned*)&xb_words);
  if (p.out == nullptr) cg::this_grid().sync();
  {
    const int NMOD = 192, NTR = 4256, NROPE = 128, NF1 = 288;
    const int nitems = NMOD + NTR + NROPE + NF1;
    for (int it = blockIdx.x; it < nitems; it += gridDim.x) {
      if (it < NMOD) mod_item(p, it, (float*)smem);
      else if (it < NMOD + NTR) {
        int t = it - NMOD;
        float* sm = (float*)smem;
        if (t < 928) { int j = t / 464; transpose_tile(p.a_w_in + (size_t)j * 1024 * 1856, p.aWin + (size_t)j * 1856 * 1024, 1024, 1856, nullptr, t % 464, sm); }
        else if ((t -= 928) < 384) { int j = t / 192; transpose_tile(p.a_w_q + (size_t)j * 512 * 1536, p.aWq + (size_t)j * 1536 * 512, 512, 1536, p.a_g_q + j * 512, t % 192, sm); }
        else if ((t -= 384) < 256) { int j = t / 128; transpose_tile(p.a_w_kv + (size_t)j * 256 * 2048, p.aWkv + (size_t)j * 2048 * 256, 256, 2048, p.a_g_kv + j * 256, t % 128, sm); }
        else if ((t -= 256) < 512) { int j = t / 256; transpose_tile(p.a_w_out + (size_t)j * 1024 * 1024, p.aWout + (size_t)j * 1024 * 1024, 1024, 1024, nullptr, t % 256, sm); }
        else if ((t -= 512) < 640) transpose_tile(p.b_w_in, p.bWin, 1024, 2560, nullptr, t, sm);
        else if ((t -= 640) < 256) transpose_tile(p.b_w_out, p.bWout, 1024, 1024, nullptr, t, sm);
        else if ((t -= 256) < 1024) transpose_tile(p.c_w_in, p.cWin, 1024, 4096, nullptr, t, sm);
        else { t -= 1024; transpose_tile(p.c_w_out, p.cWout, 1024, 1024, nullptr, t, sm); }
      }
      else if (it < NMOD + NTR + NROPE) rope_item(p, it - NMOD - NTR);
      else f1_item(p, it - NMOD - NTR - NROPE);
    }
  }
  xcd_barrier(xb);
  rowwise_phase(p, 0, nullptr);
  for (int it = blockIdx.x; it < 2048 * 9; it += gridDim.x) f2_item(p, it);
  xcd_barrier(xb);
  mla_layer(p, xb, 0, true, smem);
  rowwise_phase(p, 1, p.BIG + (size_t)ROWS * 1856);
  xcd_barrier(xb);
  {
    u16* P = p.BIG;
    u16* VT = P + (size_t)ROWS * 2560;
    u16* Y = VT + (size_t)NB * 4 * 64 * TB;
    Epi e{}; e.cosT = p.cosT; e.sinT = p.sinT;
    e.mode = E_SWA_IN; e.C = P; e.ldc = 2560; e.C2 = VT;
    gemm_phase(p.R0, 1024, p.bWin, 1024, 2560, 1024, e, false, smem);
    xcd_barrier(xb);
    AttnArgs a{}; a.Q = P; a.P = P; a.KN = nullptr; a.VT = VT; a.O = p.R0; a.sink = p.b_sink; a.with_ctx = 1;
    attn_phase<1>(a, smem);
    xcd_barrier(xb);
    e.mode = E_PLAIN; e.C = Y; e.ldc = 1024;
    gemm_phase(p.R0, 1024, p.bWout, 1024, 1024, 1024, e, false, smem);
    xcd_barrier(xb);
    rowwise_phase(p, 2, Y);
    xcd_barrier(xb);
  }
  {
    u16* PT = p.BIG;
    u16* Z = PT + (size_t)4096 * ROWS;
    Epi e{}; e.mode = E_TRANS; e.C = PT;
    gemm_phase(p.R0, 1024, p.cWin, 1024, 4096, 1024, e, false, smem);
    xcd_barrier(xb);
    shortconv_phase(p, PT);
    xcd_barrier(xb);
    conv_phase(p, 0, PT, PT, Z, smem);
    xcd_barrier(xb);
    conv_phase(p, 1, PT, Z, p.R0, smem);
    xcd_barrier(xb);
    transpose_phase(p.R0, Z, smem);
    xcd_barrier(xb);
    e.mode = E_PLAIN; e.C = p.R0; e.ldc = 1024;
    gemm_phase(Z, 1024, p.cWout, 1024, 1024, 1024, e, false, smem);
    xcd_barrier(xb);
    rowwise_phase(p, 3, p.R0);
    xcd_barrier(xb);
  }
  mla_layer(p, xb, 1, false, smem);
  rowwise_phase(p, 4, p.BIG + (size_t)ROWS * 1856);
}

extern "C" void kernel_launch(void* const* d_in, const int* in_sizes, int n_in,
                              void* d_out, int out_size, void* d_ws, size_t ws_size,
                              hipStream_t stream) {
  static int grid_blocks = 0;
  if (!grid_blocks) {
    int dev = 0, cus = 0, per_cu = 0;
    (void)hipGetDevice(&dev);
    (void)hipDeviceGetAttribute(&cus, hipDeviceAttributeMultiprocessorCount, dev);
    (void)hipFuncSetAttribute((const void*)mega, hipFuncAttributeMaxDynamicSharedMemorySize, SMEM_BYTES);
    (void)hipOccupancyMaxActiveBlocksPerMultiprocessor(&per_cu, mega, NT, SMEM_BYTES);
    if (per_cu > 1) per_cu = 1;
    if (per_cu < 1) per_cu = 1;
    grid_blocks = cus * per_cu;
  }
  Params p{};
  const float* const* in = (const float* const*)d_in;
  p.x = in[0]; p.c = in[1]; p.ctx = in[2]; p.c_ctx = in[3]; p.w_mod = in[4]; p.b_mod = in[5]; p.g_pre = in[6]; p.g_post = in[7];
  p.a_w_in = in[8]; p.a_g_q = in[9]; p.a_w_q = in[10]; p.a_g_kv = in[11]; p.a_w_kv = in[12]; p.a_w_out = in[13];
  p.b_w_in = in[14]; p.b_sink = in[15]; p.b_w_out = in[16];
  p.c_w_in = in[17]; p.c_conv_w = in[18]; p.c_conv_b = in[19]; p.c_f_w1 = in[20]; p.c_f_b1 = in[21]; p.c_f_freq = in[22];
  p.c_f_w2 = in[23]; p.c_f_b2 = in[24]; p.c_f_w3 = in[25]; p.c_filt_bias = in[26]; p.c_w_out = in[27];
  p.out = (float*)d_out;
  char* ws = (char*)d_ws;
  size_t off = 0;
  auto take = [&](size_t bytes) { char* q = ws + off; off += (bytes + 255) & ~(size_t)255; return q; };
  p.aWin = (u16*)take((size_t)2 * 1856 * 1024 * 2);
  p.aWq = (u16*)take((size_t)2 * 1536 * 512 * 2);
  p.aWkv = (u16*)take((size_t)2 * 2048 * 256 * 2);
  p.aWout = (u16*)take((size_t)2 * 1024 * 1024 * 2);
  p.bWin = (u16*)take((size_t)2560 * 1024 * 2);
  p.bWout = (u16*)take((size_t)1024 * 1024 * 2);
  p.cWin = (u16*)take((size_t)4096 * 1024 * 2);
  p.cWout = (u16*)take((size_t)1024 * 1024 * 2);
  p.mod = (float*)take((size_t)4 * 33 * 3072 * 4);
  p.cosT = (float*)take((size_t)2048 * 32 * 4);
  p.sinT = (float*)take((size_t)2048 * 32 * 4);
  p.h2 = (float*)take((size_t)2304 * 64 * 4);
  p.filt = (float*)take((size_t)2304 * 4096 * 4);
  p.ctxw = (float*)take((size_t)NB * 256 * 1024 * 4);
  p.R0 = (u16*)take((size_t)ROWS * 1024 * 2);
  p.BIG = (u16*)take((size_t)ROWS * (1856 + 1536 + 1024 + 1024) * 2);
  p.bar = (unsigned*)take((size_t)XCD_BAR_WORDS * 4);
  if (off > ws_size) { fprintf(stderr, "workspace too small: need %zu have %zu\n", off, ws_size); return; }
  (void)hipMemsetAsync(p.bar, 0, (size_t)XCD_BAR_WORDS * 4, stream);
  void* args[] = {&p};
  hipError_t e = hipLaunchCooperativeKernel((void*)mega, dim3(grid_blocks), dim3(NT), args, SMEM_BYTES, stream);
  if (e != hipSuccess) fprintf(stderr, "coop launch failed: %s (grid %d)\n", hipGetErrorString(e), grid_blocks);
}
```

```cpp
#include <hip/hip_runtime.h>
#include <hip/hip_cooperative_groups.h>
#include <cstdio>
#include <cmath>
namespace cg = cooperative_groups;

typedef unsigned short u16;
typedef __attribute__((ext_vector_type(8))) short bf16x8;
typedef __attribute__((ext_vector_type(16))) float f32x16;
typedef __attribute__((ext_vector_type(4))) unsigned u32x4;

#define DI __device__ __forceinline__
constexpr int NB = 32, TB = 2304, ROWS = NB * TB;
constexpr float EPS = 1e-6f;
constexpr float LOG2E = 1.4426950408889634f;
constexpr int SMEM_BYTES = 149504;
constexpr int NT = 512, NW = 8;

struct Params {
  const float *x, *c, *ctx, *c_ctx, *w_mod, *b_mod, *g_pre, *g_post;
  const float *a_w_in, *a_g_q, *a_w_q, *a_g_kv, *a_w_kv, *a_w_out;
  const float *b_w_in, *b_sink, *b_w_out;
  const float *c_w_in, *c_conv_w, *c_conv_b, *c_f_w1, *c_f_b1, *c_f_freq, *c_f_w2, *c_f_b2, *c_f_w3, *c_filt_bias, *c_w_out;
  float* out;
  u16 *aWin, *aWq, *aWkv, *aWout, *bWin, *bWout, *cWin, *cWout;
  float *mod, *cosT, *sinT, *h2, *filt, *ctxw;
  u16 *R0, *BIG;
  unsigned* bar;
};

typedef __attribute__((ext_vector_type(2))) __bf16 bf16v2;
typedef __attribute__((ext_vector_type(2))) float f32v2;
DI unsigned pack2(float a, float b) { f32v2 v = {a, b}; return __builtin_bit_cast(unsigned, __builtin_convertvector(v, bf16v2)); }
DI u16 f2bf(float x) { return (u16)(pack2(x, 0.f) & 0xffffu); }
DI float bf2f(u16 v) { return __uint_as_float(((unsigned)v) << 16); }
DI float siluf(float v) { return v * __builtin_amdgcn_rcpf(1.f + __expf(-v)); }
DI f32x16 mfma32(bf16x8 a, bf16x8 b, f32x16 c) { return __builtin_amdgcn_mfma_f32_32x32x16_bf16(a, b, c, 0, 0, 0); }
DI int get_tid() { int t = threadIdx.x; asm volatile("" : "+v"(t)); return t; }
DI f32x16 zero16() { f32x16 z; for (int i = 0; i < 16; ++i) z[i] = 0.f; return z; }


#define XB_TMO      128
#define XB_XCNT(j)  (256  + 64 * (j))
#define XB_XSUB(j)  (1280 + 64 * (j))
#define XB_XGEN(j)  (2304 + 64 * (j))
#define XB_TOP      3328
#define XB_TOPGEN   3392
#define XCD_BAR_WORDS 3456
#define XB_SPIN_CAP (1u << 20)
#define LAS __attribute__((address_space(3)))
DI unsigned xb_ld(unsigned* p)              { return __hip_atomic_load(p, __ATOMIC_RELAXED, __HIP_MEMORY_SCOPE_AGENT); }
DI unsigned xb_add(unsigned* p, unsigned v) { return __hip_atomic_fetch_add(p, v, __ATOMIC_RELAXED, __HIP_MEMORY_SCOPE_AGENT); }
DI unsigned xb_xcc_id() { return (unsigned)__builtin_amdgcn_s_getreg((3 << 11) | 20) & 0xFu; }
#define XB_SPIN(cond, bar) do { unsigned _sp = 0; while (cond) { __builtin_amdgcn_s_sleep(1); \
    if ((++_sp & 255u) == 0u) { if (xb_ld(&(bar)[XB_TMO])) break; if (_sp > XB_SPIN_CAP) { atomicAdd(&(bar)[XB_TMO], 1u); break; } } } } while (0)
struct XcdBarrier { unsigned* bar; unsigned x; volatile LAS unsigned* st; };
DI XcdBarrier xcd_barrier_post(unsigned* bar, volatile LAS unsigned* st) {
  XcdBarrier b; b.bar = bar; b.x = xb_xcc_id(); b.st = st;
  if (threadIdx.x == 0) (void)xb_add(&bar[XB_XCNT(b.x)], 1u);
  return b;
}
DI void xcd_barrier_complete(unsigned* bar, unsigned x, unsigned& nloc, unsigned& nx) {
  const unsigned G = gridDim.x * gridDim.y * gridDim.z;
  unsigned sum, cnt, mine, sp = 0u;
  for (;;) {
    sum = 0u; cnt = 0u; mine = 0u;
#pragma unroll
    for (unsigned j = 0; j < 16; ++j) { const unsigned c = xb_ld(&bar[XB_XCNT(j)]); sum += c; cnt += (c > 0u) ? 1u : 0u; mine = (j == x) ? c : mine; }
    if (sum == G) break;
    __builtin_amdgcn_s_sleep(1);
    if ((++sp & 255u) == 0u) { if (xb_ld(&bar[XB_TMO])) break; if (sp > XB_SPIN_CAP) { atomicAdd(&bar[XB_TMO], 1u); break; } }
  }
  nloc = mine > 0u ? mine : 1u; nx = cnt > 0u ? cnt : 1u;
}
DI void xcd_barrier(const XcdBarrier& b) {
  asm volatile("s_waitcnt vmcnt(0)" ::: "memory");
  __syncthreads();
  if (threadIdx.x == 0) {
    unsigned* bar = b.bar;
    __builtin_amdgcn_s_waitcnt(0);
    unsigned nloc = b.st[0], nx = b.st[1];
    if (nloc == 0u) { xcd_barrier_complete(bar, b.x, nloc, nx); b.st[0] = nloc; b.st[1] = nx; }
    const unsigned old = xb_add(&bar[XB_XSUB(b.x)], 1u);
    const unsigned gen = old / nloc;
    if (old + 1u == (gen + 1u) * nloc) {
      __builtin_amdgcn_fence(__ATOMIC_RELEASE, "agent");
      asm volatile("s_waitcnt vmcnt(0)" ::: "memory");
      const unsigned og = xb_add(&bar[XB_TOP], 1u);
      const unsigned tg = og / nx;
      if (og + 1u == (tg + 1u) * nx) xb_add(&bar[XB_TOPGEN], 1u);
      else XB_SPIN(xb_ld(&bar[XB_TOPGEN]) == tg, bar);
      __builtin_amdgcn_fence(__ATOMIC_ACQUIRE, "agent");
      xb_add(&bar[XB_XGEN(b.x)], 1u);
      asm volatile("s_waitcnt vmcnt(0)" ::: "memory");
    } else {
      XB_SPIN(xb_ld(&bar[XB_XGEN(b.x)]) == gen, bar);
      __builtin_amdgcn_fence(__ATOMIC_ACQUIRE, "agent");
      asm volatile("s_waitcnt vmcnt(0)" ::: "memory");
    }
  }
  __syncthreads();
}

DI void transpose_tile(const float* __restrict__ W, u16* __restrict__ Wt, int K, int N, const float* __restrict__ gain,
                       int tile, float* sm) {
  const int ntn = N / 64, tk = tile / ntn, tn = tile % ntn, k0 = tk * 64, n0 = tn * 64, tid = threadIdx.x;
  for (int i = 0; i < 8; ++i) {
    int kk = (tid >> 6) + 8 * i, nn = tid & 63;
    float v = W[(size_t)(k0 + kk) * N + n0 + nn];
    if (gain) v *= gain[k0 + kk];
    sm[nn * 65 + kk] = v;
  }
  __syncthreads();
  for (int i = 0; i < 8; ++i) {
    int nn = (tid >> 6) + 8 * i, kk = tid & 63;
    Wt[(size_t)(n0 + nn) * K + k0 + kk] = f2bf(sm[nn * 65 + kk]);
  }
  __syncthreads();
}

DI void mod_item(const Params& p, int it, float* sm) {
  const int tid = get_tid(), col = tid & 63, kg = tid >> 6;
  const int l = it / 48, j = (it % 48) * 64 + col;
  float* sc = sm + kg * (33 * 64);
  float acc[33];
#pragma unroll
  for (int r = 0; r < 33; ++r) acc[r] = 0.f;
  __syncthreads();
  for (int k0 = kg * 128; k0 < kg * 128 + 128; k0 += 64) {
    for (int idx = col; idx < 33 * 64; idx += 64) {
      int r = idx >> 6, kk = idx & 63;
      float cv = (r < 32) ? p.c[r * 1024 + k0 + kk] : p.c_ctx[k0 + kk];
      sc[idx] = cv / (1.f + expf(-cv));
    }
    __syncthreads();
    for (int kk = 0; kk < 64; kk += 4) {
      float w0 = p.w_mod[((size_t)l * 1024 + k0 + kk) * 3072 + j];
      float w1 = p.w_mod[((size_t)l * 1024 + k0 + kk + 1) * 3072 + j];
      float w2 = p.w_mod[((size_t)l * 1024 + k0 + kk + 2) * 3072 + j];
      float w3 = p.w_mod[((size_t)l * 1024 + k0 + kk + 3) * 3072 + j];
#pragma unroll
      for (int r = 0; r < 33; ++r) {
        float4 s4 = *(const float4*)&sc[r * 64 + kk];
        acc[r] += s4.x * w0 + s4.y * w1 + s4.z * w2 + s4.w * w3;
      }
    }
    __syncthreads();
  }
  float* red = sm;
#pragma unroll
  for (int r = 0; r < 33; ++r) red[(kg * 33 + r) * 64 + col] = acc[r];
  __syncthreads();
  const float bm = p.b_mod[l * 3072 + j];
  for (int r = kg; r < 33; r += 8) {
    float t = 0.f;
#pragma unroll
    for (int g = 0; g < 8; ++g) t += red[(g * 33 + r) * 64 + col];
    p.mod[((size_t)l * 33 + r) * 3072 + j] = t + bm;
  }
  __syncthreads();
}

DI void rope_item(const Params& p, int it) {
  int idx = it * 512 + threadIdx.x;
  int pos = idx >> 5, a = idx & 31, i = a & 15;
  float inv = powf(10000.f, -(float)(2 * i) / 32.f);
  float v = (float)((a < 16) ? (pos >> 6) : (pos & 63)) * inv;
  p.cosT[idx] = cosf(v);
  p.sinT[idx] = sinf(v);
}

DI void f1_item(const Params& p, int it) {
  const int w = threadIdx.x >> 6, j = threadIdx.x & 63;
  const int pidx = it * 8 + w;
  const int n = pidx < 2048 ? 2048 : 256, t = pidx < 2048 ? pidx : pidx - 2048;
  const float tl = (float)t / (float)(n - 1);
  const float wv = (n == 2048 ? (float)(2.0 * M_PI / 2048.0) : (float)(2.0 * M_PI / 256.0)) * (float)t;
  const float bstep = (15.f - 1e-4f) / 15.f;
  float z = 0.f;
  if (j == 0) z = tl;
  else if (j <= 16) z = cosf((1e-4f + (float)(j - 1) * bstep) * wv);
  else if (j <= 32) z = -sinf((1e-4f + (float)(j - 17) * bstep) * wv);
  const float fr = p.c_f_freq[j];
  float h1 = p.c_f_b1[j];
  for (int k = 0; k < 33; ++k) h1 += __shfl(z, k) * p.c_f_w1[k * 64 + j];
  h1 = sinf(fr * h1);
  float h2 = p.c_f_b2[j];
  for (int k = 0; k < 64; ++k) h2 += __shfl(h1, k) * p.c_f_w2[k * 64 + j];
  h2 = sinf(fr * h2);
  p.h2[pidx * 64 + j] = h2;
}

DI void f2_item(const Params& p, int it) {
  const int col = (it / 9) * 2 + (threadIdx.x >> 8), tc = it % 9, tid = threadIdx.x & 255;
  const int pidx = tc * 256 + tid;
  const int n = tc < 8 ? 2048 : 256, t = tc < 8 ? pidx : tid;
  const float4* hp = (const float4*)(p.h2 + (size_t)pidx * 64);
  float acc = 0.f;
  for (int q = 0; q < 16; ++q) {
    float4 hv = hp[q];
    acc += hv.x * p.c_f_w3[(q * 4 + 0) * 4096 + col];
    acc += hv.y * p.c_f_w3[(q * 4 + 1) * 4096 + col];
    acc += hv.z * p.c_f_w3[(q * 4 + 2) * 4096 + col];
    acc += hv.w * p.c_f_w3[(q * 4 + 3) * 4096 + col];
  }
  const int c = col & 1023;
  const float dmin = logf(0.01f) / 1.5f, dmax = logf(0.01f) / 0.3f;
  const float delta = fabsf(dmin + (float)c * ((dmax - dmin) / 1023.f));
  const float tl = (float)t / (float)(n - 1);
  float v = acc * expf(-tl * delta);
  if (tc < 8) p.filt[(size_t)col * 2048 + t] = v;
  else p.filt[(size_t)4096 * 2048 + (size_t)col * 256 + t] = v;
}

DI float wave_sum(float v) {
  for (int o = 32; o >= 1; o >>= 1) v += __shfl_xor(v, o);
  return v;
}

DI void rowwise_phase(const Params& p, int l, const u16* __restrict__ Y, float* dlat = nullptr, float* dctx = nullptr, u16* dh = nullptr) {
  const int tid0 = get_tid(); const int lane = tid0 & 63, w = tid0 >> 6;
  for (int R = blockIdx.x * NW + w; R < ROWS; R += gridDim.x * NW) {
    const int b = R / TB, i = R % TB;
    const bool isctx = i < 256;
    if (isctx && l == 4) continue;
    const int mr = isctx ? 32 : b;
    float* xres = isctx ? p.ctxw + ((size_t)b * 256 + i) * 1024 : p.out + ((size_t)b * 2048 + (i - 256)) * 1024;
    const float* xin = (l == 0) ? (isctx ? p.ctx + ((size_t)b * 256 + i) * 1024 : p.x + ((size_t)b * 2048 + (i - 256)) * 1024) : xres;
    float xv[16];
#pragma unroll
    for (int k = 0; k < 4; ++k) {
      float4 v = *(const float4*)(xin + k * 256 + lane * 4);
      xv[4 * k] = v.x; xv[4 * k + 1] = v.y; xv[4 * k + 2] = v.z; xv[4 * k + 3] = v.w;
    }
    if (l > 0) {
      float yv[16], ss = 0.f;
#pragma unroll
      for (int k = 0; k < 4; ++k) {
        uint2 v = *(const uint2*)(Y + (size_t)R * 1024 + k * 256 + lane * 4);
        yv[4 * k] = bf2f((u16)(v.x & 0xffff)); yv[4 * k + 1] = bf2f((u16)(v.x >> 16));
        yv[4 * k + 2] = bf2f((u16)(v.y & 0xffff)); yv[4 * k + 3] = bf2f((u16)(v.y >> 16));
      }
#pragma unroll
      for (int e = 0; e < 16; ++e) ss += yv[e] * yv[e];
      ss = wave_sum(ss);
      const float rinv = rsqrtf(ss * (1.f / 1024.f) + EPS);
      const float* gp = p.g_post + (l - 1) * 1024;
      const float* gt = p.mod + ((size_t)(l - 1) * 33 + mr) * 3072 + 2048;
#pragma unroll
      for (int k = 0; k < 4; ++k) {
        float4 g4 = *(const float4*)(gp + k * 256 + lane * 4);
        float4 t4 = *(const float4*)(gt + k * 256 + lane * 4);
        xv[4 * k] += t4.x * (yv[4 * k] * rinv * g4.x);
        xv[4 * k + 1] += t4.y * (yv[4 * k + 1] * rinv * g4.y);
        xv[4 * k + 2] += t4.z * (yv[4 * k + 2] * rinv * g4.z);
        xv[4 * k + 3] += t4.w * (yv[4 * k + 3] * rinv * g4.w);
      }
    }
    float* xdst = xres;
    if (dlat) xdst = isctx ? dctx + ((size_t)b * 256 + i) * 1024 : dlat + ((size_t)b * 2048 + (i - 256)) * 1024;
#pragma unroll
    for (int k = 0; k < 4; ++k) {
      float4 v; v.x = xv[4 * k]; v.y = xv[4 * k + 1]; v.z = xv[4 * k + 2]; v.w = xv[4 * k + 3];
      *(float4*)(xdst + k * 256 + lane * 4) = v;
    }
    if (l < 4) {
      float ss = 0.f;
#pragma unroll
      for (int e = 0; e < 16; ++e) ss += xv[e] * xv[e];
      ss = wave_sum(ss);
      const float rinv = rsqrtf(ss * (1.f / 1024.f) + EPS);
      const float* gp = p.g_pre + l * 1024;
      const float* md = p.mod + ((size_t)l * 33 + mr) * 3072;
#pragma unroll
      for (int k = 0; k < 4; ++k) {
        float4 g4 = *(const float4*)(gp + k * 256 + lane * 4);
        float4 sh = *(const float4*)(md + k * 256 + lane * 4);
        float4 sc = *(const float4*)(md + 1024 + k * 256 + lane * 4);
        float h0 = xv[4 * k] * rinv * g4.x * (1.f + sc.x) + sh.x;
        float h1 = xv[4 * k + 1] * rinv * g4.y * (1.f + sc.y) + sh.y;
        float h2 = xv[4 * k + 2] * rinv * g4.z * (1.f + sc.z) + sh.z;
        float h3 = xv[4 * k + 3] * rinv * g4.w * (1.f + sc.w) + sh.w;
        uint2 o; o.x = pack2(h0, h1); o.y = pack2(h2, h3);
        *(uint2*)((dh ? dh : p.R0) + (size_t)R * 1024 + k * 256 + lane * 4) = o;
      }
    }
  }
}

enum { E_PLAIN = 0, E_MLA_IN, E_MLA_Q, E_MLA_KV, E_SWA_IN, E_TRANS };
struct Epi { int mode; u16* C; int ldc; u16* C2; const float* cosT; const float* sinT; };

DI void store_plain(u16* __restrict__ C, int ldc, int row0, int col0, const f32x16 (&acc)[2][2], int r, int h) {
#pragma unroll
  for (int mi = 0; mi < 2; ++mi)
#pragma unroll
    for (int ni = 0; ni < 2; ++ni)
#pragma unroll
      for (int i = 0; i < 16; ++i) {
        int row = row0 + 32 * mi + (i & 3) + 8 * (i >> 2) + 4 * h;
        C[(size_t)row * ldc + col0 + 32 * ni + r] = f2bf(acc[mi][ni][i]);
      }
}
DI void store_trans(u16* __restrict__ T, size_t ldt, size_t colbase, size_t tokbase, const f32x16 (&acc)[2][2], int r, int h, u16* st) {
#pragma unroll
  for (int mi = 0; mi < 2; ++mi)
#pragma unroll
    for (int ni = 0; ni < 2; ++ni)
#pragma unroll
      for (int g = 0; g < 4; ++g) {
        uint2 o;
        o.x = pack2(acc[mi][ni][4 * g], acc[mi][ni][4 * g + 1]);
        o.y = pack2(acc[mi][ni][4 * g + 2], acc[mi][ni][4 * g + 3]);
        *(uint2*)&st[(32 * ni + r) * 72 + 32 * mi + 8 * g + 4 * h] = o;
      }
  const int lane = r + 32 * h;
#pragma unroll
  for (int j = 0; j < 8; ++j) {
    const int chunk = j * 64 + lane, ch = chunk >> 3, t8 = (chunk & 7) * 8;
    const u32x4 v = *(const u32x4*)&st[ch * 72 + t8];
    *(u32x4*)(T + (colbase + ch) * ldt + tokbase + t8) = v;
  }
}
DI void rope_acc(const Epi& e, int row0, f32x16 (&acc)[2][2], int r, int h) {
  const int ib = row0 % TB;
  if (ib < 256) return;
#pragma unroll
  for (int mi = 0; mi < 2; ++mi)
#pragma unroll
    for (int i = 0; i < 16; ++i) {
      int pos = ib - 256 + 32 * mi + (i & 3) + 8 * (i >> 2) + 4 * h;
      float cs = e.cosT[pos * 32 + r], sn = e.sinT[pos * 32 + r];
      float x1 = acc[mi][0][i], x2 = acc[mi][1][i];
      acc[mi][0][i] = x1 * cs - x2 * sn;
      acc[mi][1][i] = x1 * sn + x2 * cs;
      if ((i & 3) == 3) __builtin_amdgcn_sched_barrier(0);
    }
}

DI void scale_acc(f32x16 (&acc)[2][2], float sc) {
#pragma unroll
  for (int mi = 0; mi < 2; ++mi)
#pragma unroll
    for (int ni = 0; ni < 2; ++ni)
#pragma unroll
      for (int i = 0; i < 16; ++i) acc[mi][ni][i] *= sc;
}
DI void epilogue(const Epi& e, int row0, int col0, f32x16 (&acc)[2][2], int r, int h, u16* st) {
  const int b = row0 / TB, ib = row0 % TB;
  switch (e.mode) {
    case E_PLAIN: store_plain(e.C, e.ldc, row0, col0, acc, r, h); break;
    case E_MLA_IN:
      if (col0 == 768) rope_acc(e, row0, acc, r, h);
      store_plain(e.C, e.ldc, row0, col0, acc, r, h); break;
    case E_MLA_Q:
      if ((col0 % 192) == 128) rope_acc(e, row0, acc, r, h);
      scale_acc(acc, 0.07216878364870322f * LOG2E);
      store_plain(e.C, e.ldc, row0, col0, acc, r, h); break;
    case E_MLA_KV: {
      int head = col0 >> 8, within = col0 & 255;
      if (within < 128) store_plain(e.C + head * 128 + within - col0, 1024, row0, col0, acc, r, h);
      else store_trans(e.C2, TB, (size_t)(b * 8 + head) * 128 + (within - 128), ib, acc, r, h, st);
    } break;
    case E_SWA_IN:
      if (col0 < 1280) { rope_acc(e, row0, acc, r, h); if (col0 < 1024) scale_acc(acc, 0.125f * LOG2E); store_plain(e.C, e.ldc, row0, col0, acc, r, h); }
      else if (col0 < 1536) { int kvh = (col0 - 1280) >> 6; store_trans(e.C2, TB, (size_t)(b * 4 + kvh) * 64, ib, acc, r, h, st); }
      else store_plain(e.C, e.ldc, row0, col0, acc, r, h);
      break;
    case E_TRANS: store_trans(e.C, ROWS, col0, row0, acc, r, h, st); break;
  }
}

DI void gemm_tile(const u16* __restrict__ A, int lda, const u16* __restrict__ Bt, int ldb, int N, int K,
                  int tm, int tn, const Epi& e, bool rownorm, char* smem) {
  constexpr int LS = 72;
  constexpr int STAGE = 512 * LS;
  u16* S0 = (u16*)smem;
  float* rs = (float*)(S0 + 2 * STAGE);
  const int tid = get_tid(), lane = tid & 63, w = tid >> 6, r = lane & 31, h = lane >> 5;
  const int wm = w >> 2, wn = w & 3;
  const int lr = tid >> 3, lk = (tid & 7) * 8;
  const u16* ap = A + (size_t)(tm * 256 + lr) * lda + lk;
  const u16* bp = Bt + (size_t)(tn * 256 + lr) * ldb + lk;
  const size_t a64 = (size_t)64 * lda, b64 = (size_t)64 * ldb;
  __syncthreads();
  float rss = 0.f;
  f32x16 acc[2][2][2];
#pragma unroll
  for (int hf = 0; hf < 2; ++hf)
#pragma unroll
    for (int mi = 0; mi < 2; ++mi)
#pragma unroll
      for (int ni = 0; ni < 2; ++ni) acc[hf][mi][ni] = zero16();
  u32x4 ra[4], rb[4];
#pragma unroll
  for (int i = 0; i < 4; ++i) { ra[i] = *(const u32x4*)(ap + i * a64); rb[i] = *(const u32x4*)(bp + i * b64); }
  u16* wa = S0 + lr * LS + lk;
#pragma unroll
  for (int i = 0; i < 4; ++i) { *(u32x4*)(wa + i * 64 * LS) = ra[i]; *(u32x4*)(wa + 256 * LS + i * 64 * LS) = rb[i]; }
  __syncthreads();
  const int nk = K >> 6;
  {
    const int ko = min(1, nk - 1) * 64;
#pragma unroll
    for (int i = 0; i < 4; ++i) { ra[i] = *(const u32x4*)(ap + i * a64 + ko); rb[i] = *(const u32x4*)(bp + i * b64 + ko); }
  }
  const u16* as0 = S0 + (wm * 128 + r) * LS + 8 * h;
  const u16* bs0 = S0 + 256 * LS + (wn * 64 + r) * LS + 8 * h;
#pragma unroll 1
  for (int kt = 0; kt < nk; ++kt) {
    const int cur = kt & 1;
    {
      u16* wn_ = wa + (cur ^ 1) * STAGE;
#pragma unroll
      for (int i = 0; i < 4; ++i) { *(u32x4*)(wn_ + i * 64 * LS) = ra[i]; *(u32x4*)(wn_ + 256 * LS + i * 64 * LS) = rb[i]; }
      const int ko = min(kt + 2, nk - 1) * 64;
#pragma unroll
      for (int i = 0; i < 4; ++i) { ra[i] = *(const u32x4*)(ap + i * a64 + ko); rb[i] = *(const u32x4*)(bp + i * b64 + ko); }
    }
    __builtin_amdgcn_sched_barrier(0);
    const u16* as = as0 + cur * STAGE;
    const u16* bs = bs0 + cur * STAGE;
    __builtin_amdgcn_s_setprio(1);
#pragma unroll
    for (int s = 0; s < 4; ++s) {
      bf16x8 af[4], bfr[2];
#pragma unroll
      for (int q = 0; q < 4; ++q) af[q] = *(const bf16x8*)&as[q * 32 * LS + 16 * s];
#pragma unroll
      for (int ni = 0; ni < 2; ++ni) bfr[ni] = *(const bf16x8*)&bs[ni * 32 * LS + 16 * s];
#pragma unroll
      for (int q = 0; q < 4; ++q)
#pragma unroll
        for (int ni = 0; ni < 2; ++ni) acc[q >> 1][q & 1][ni] = mfma32(af[q], bfr[ni], acc[q >> 1][q & 1][ni]);
    }
    __builtin_amdgcn_s_setprio(0);
    if (rownorm) {
      const u16* rp = S0 + cur * STAGE + (tid >> 1) * LS + (tid & 1) * 32;
#pragma unroll
      for (int q4 = 0; q4 < 4; ++q4) {
        const u32x4 v = *(const u32x4*)(rp + 8 * q4);
#pragma unroll
        for (int q = 0; q < 4; ++q) {
          const float a0 = bf2f((u16)(v[q] & 0xffff)), a1 = bf2f((u16)(v[q] >> 16));
          rss += a0 * a0 + a1 * a1;
        }
      }
    }
    __builtin_amdgcn_sched_barrier(0);
    __syncthreads();
  }
  if (rownorm) {
    rss += __shfl_xor(rss, 1);
    if ((tid & 1) == 0) rs[tid >> 1] = rsqrtf(rss / (float)K + EPS);
    __syncthreads();
  }
  const int row0 = tm * 256 + wm * 128, col0 = tn * 256 + wn * 64;
  if (col0 >= N) return;
#pragma unroll
  for (int hf = 0; hf < 2; ++hf) {
    if (rownorm) {
#pragma unroll
      for (int mi = 0; mi < 2; ++mi)
#pragma unroll
        for (int i = 0; i < 16; ++i) {
          float sc = rs[wm * 128 + 64 * hf + 32 * mi + (i & 3) + 8 * (i >> 2) + 4 * h];
          acc[hf][mi][0][i] *= sc; acc[hf][mi][1][i] *= sc;
        }
    }
    epilogue(e, row0 + 64 * hf, col0, acc[hf], r, h, S0 + w * (64 * 72));
  }
}

DI void gemm_phase(const u16* A, int lda, const u16* Bt, int ldb, int N, int K, const Epi& e, bool rownorm, char* smem) {
  const int ntn = (N + 255) / 256;
  if ((gridDim.x & 7) == 0) {
    const int x = blockIdx.x & 7, slot = blockIdx.x >> 3, per = gridDim.x >> 3, nl = (ROWS / 256 / 8) * ntn;
    for (int li = slot; li < nl; li += per) gemm_tile(A, lda, Bt, ldb, N, K, (li / ntn) * 8 + x, li % ntn, e, rownorm, smem);
  } else {
    const int ntiles = (ROWS / 256) * ntn;
    for (int t = blockIdx.x; t < ntiles; t += gridDim.x) gemm_tile(A, lda, Bt, ldb, N, K, t / ntn, t % ntn, e, rownorm, smem);
  }
}

struct AttnArgs {
  const u16* Q; const u16* P; const u16* KN; const u16* VT; u16* O; const float* sink; int with_ctx;
};

DI int perm32(int r) { return (r & ~12) | ((r & 4) << 1) | ((r & 8) >> 1); }

template <int MODE>
DI void attn_unit(const AttnArgs& a, int b, int head, int qb, bool isctx, char* smem) {
  constexpr int H = MODE == 0 ? 8 : 16, DQK = MODE == 0 ? 192 : 64, DV = MODE == 0 ? 128 : 64;
  constexpr int HKV = MODE == 0 ? 8 : 4, KS = DQK + 8, VS = 72, NS = DQK / 16, NDV = DV / 32;
  constexpr int LDQ = MODE == 0 ? 1536 : 2560, LDP = MODE == 0 ? 1856 : 2560, GOFF = MODE == 0 ? 832 : 1536;
  u16* Ks = (u16*)smem;
  u16* Vts = Ks + 64 * KS;
  const int tid = get_tid(), lane = tid & 63, w = tid >> 6, r = lane & 31, h = lane >> 5;
  const int hkv = MODE == 0 ? head : (head >> 2);
  const int qi = (isctx ? 0 : 256) + qb * 256 + w * 32 + r;
  const size_t Rq = (size_t)b * TB + qi;
  const int qpos = qb * 256 + w * 32 + r;
  bf16x8 qf[NS];
  {
    const u16* qp = a.Q + Rq * LDQ + head * DQK + 8 * h;
#pragma unroll
    for (int s = 0; s < NS; ++s) qf[s] = *(const bf16x8*)(qp + 16 * s);
  }
  float m = -1e30f, l = 0.f;
  if (MODE == 1) { m = a.sink[head] * LOG2E; l = (h == 0) ? 1.f : 0.f; }
  f32x16 oacc[NDV];
#pragma unroll
  for (int d = 0; d < NDV; ++d) oacc[d] = zero16();
  int tb_lo = 0, ntiles;
  if (isctx) ntiles = 4;
  else if (MODE == 0) ntiles = 36;
  else { tb_lo = (qb == 0) ? 2 : 0; const int tb_hi = (qb == 7) ? 5 : 9; ntiles = 4 + (tb_hi - tb_lo + 1); }
  const int pr = perm32(r);
  constexpr int NKL = MODE == 0 ? 3 : 1, NVL = DV / 64;
  u32x4 kreg[NKL], vreg[NVL];
  auto tile_kb = [=](int t) -> int {
    if (MODE == 1 && t >= 4) return 256 + qb * 256 - 128 + 64 * (tb_lo + t - 4);
    return 64 * t;
  };
  const int lrow = tid >> 3, lq = tid & 7;
  const u16* kbase = MODE == 0 ? a.KN + ((size_t)b * TB + lrow) * 1024 + head * 128 + lq * 8
                               : a.P + ((size_t)b * TB + lrow) * LDP + 1024 + hkv * 64 + lq * 8;
  const u16* krbase = a.P + ((size_t)b * TB + lrow) * LDP + 768 + lq * 8;
  const int vrow = MODE == 0 ? (tid >> 2) : (tid >> 3), vq = MODE == 0 ? (tid & 3) * 8 : (tid & 7) * 8;
  const u16* vbase = a.VT + ((size_t)(b * HKV + hkv) * DV + vrow) * TB + vq;
  u16* kdst = Ks + lrow * KS + lq * 8;
  u16* krdst = Ks + lrow * KS + 128 + lq * 8;
  u16* vdst = Vts + vrow * VS + vq;
#define ATTN_ISSUE_LOADS(T) do { \
    const int kb_ = tile_kb(T); \
    if (MODE == 0) { \
      const u16* kp_ = kbase + (size_t)kb_ * 1024; \
      const u16* rp_ = krbase + (size_t)kb_ * LDP; \
      kreg[0] = *(const u32x4*)kp_; kreg[1] = *(const u32x4*)(kp_ + 64); kreg[NKL - 1] = *(const u32x4*)rp_; \
    } else { \
      kreg[0] = *(const u32x4*)(kbase + (size_t)kb_ * LDP); \
    } \
    const u16* vp_ = vbase + kb_; \
    _Pragma("unroll") for (int i_ = 0; i_ < NVL; ++i_) vreg[i_] = *(const u32x4*)(vp_ + 32 * i_); \
  } while (0)
  constexpr int ASTAGE = 64 * KS + DV * VS;
#define ATTN_WRITE_STAGE(ST) do { \
    u16* kd_ = kdst + (ST) * ASTAGE; u16* krd_ = krdst + (ST) * ASTAGE; u16* vd_ = vdst + (ST) * ASTAGE; \
    if (MODE == 0) { *(u32x4*)kd_ = kreg[0]; *(u32x4*)(kd_ + 64) = kreg[1]; *(u32x4*)krd_ = kreg[NKL - 1]; } \
    else { *(u32x4*)kd_ = kreg[0]; } \
    _Pragma("unroll") for (int i_ = 0; i_ < NVL; ++i_) *(u32x4*)(vd_ + 32 * i_) = vreg[i_]; \
  } while (0)
  ATTN_ISSUE_LOADS(0);
  __syncthreads();
  ATTN_WRITE_STAGE(0);
  __syncthreads();
  ATTN_ISSUE_LOADS(min(1, ntiles - 1));
#pragma unroll 1
  for (int t = 0; t < ntiles; ++t) {
    const bool band = (MODE == 1 && t >= 4);
    const int kpos0 = tile_kb(t) - 256;
    const int cur = t & 1;
    ATTN_WRITE_STAGE(cur ^ 1);
    ATTN_ISSUE_LOADS(min(t + 2, ntiles - 1));
    __builtin_amdgcn_sched_barrier(0);
    bool skip = false;
    if (MODE == 1 && band) {
      int q0 = qb * 256 + w * 32;
      skip = (kpos0 + 63 < q0 - 128 || kpos0 > q0 + 31 + 128);
    }
    if (!skip) {
    const u16* Kc = Ks + cur * ASTAGE;
    const u16* Vc = Vts + cur * ASTAGE;
    f32x16 sacc[2];
    sacc[0] = zero16(); sacc[1] = zero16();
    {
      const u16* kp0 = &Kc[pr * KS + 8 * h];
      const u16* kp1 = kp0 + 32 * KS;
      bf16x8 k0 = *(const bf16x8*)kp0, k1 = *(const bf16x8*)kp1;
#pragma unroll
      for (int s = 0; s < NS; ++s) {
        bf16x8 n0 = k0, n1 = k1;
        if (s + 1 < NS) { n0 = *(const bf16x8*)(kp0 + 16 * (s + 1)); n1 = *(const bf16x8*)(kp1 + 16 * (s + 1)); }
        sacc[0] = mfma32(k0, qf[s], sacc[0]);
        sacc[1] = mfma32(k1, qf[s], sacc[1]);
        k0 = n0; k1 = n1;
      }
    }
    float mx = -1e30f;
#pragma unroll
    for (int u = 0; u < 2; ++u)
#pragma unroll
      for (int i = 0; i < 16; ++i) {
        float sv = sacc[u][i];
        if (MODE == 1 && band) {
          int kpos = kpos0 + 32 * u + (i & 7) + 8 * h + 16 * (i >> 3);
          int d = qpos - kpos;
          if (d > 128 || d < -128) sv = -1e30f;
          sacc[u][i] = sv;
        }
        mx = fmaxf(mx, sv);
      }
    mx = fmaxf(mx, __shfl_xor(mx, 32));
    if (__builtin_amdgcn_ballot_w64(mx > m + 8.f) != 0ull) {
      const float mnew = fmaxf(m, mx);
      const float alpha = __builtin_amdgcn_exp2f(m - mnew);
      m = mnew;
      l *= alpha;
#pragma unroll
      for (int d = 0; d < NDV; ++d)
#pragma unroll
        for (int i = 0; i < 16; ++i) oacc[d][i] *= alpha;
    }
    float ls = 0.f;
#pragma unroll
    for (int u = 0; u < 2; ++u)
#pragma unroll
      for (int i = 0; i < 16; ++i) { float pv = __builtin_amdgcn_exp2f(sacc[u][i] - m); sacc[u][i] = pv; ls += pv; }
    l += ls;
    bf16x8 pf[2][2];
#pragma unroll
    for (int u = 0; u < 2; ++u)
#pragma unroll
      for (int s2 = 0; s2 < 2; ++s2) {
        u32x4 t4;
        t4[0] = pack2(sacc[u][8 * s2 + 0], sacc[u][8 * s2 + 1]); t4[1] = pack2(sacc[u][8 * s2 + 2], sacc[u][8 * s2 + 3]);
        t4[2] = pack2(sacc[u][8 * s2 + 4], sacc[u][8 * s2 + 5]); t4[3] = pack2(sacc[u][8 * s2 + 6], sacc[u][8 * s2 + 7]);
        pf[u][s2] = __builtin_bit_cast(bf16x8, t4);
      }
#pragma unroll
    for (int u = 0; u < 2; ++u)
#pragma unroll
      for (int s2 = 0; s2 < 2; ++s2) {
        bf16x8 vf[NDV];
#pragma unroll
        for (int d = 0; d < NDV; ++d) vf[d] = *(const bf16x8*)&Vc[(d * 32 + r) * VS + 32 * u + 16 * s2 + 8 * h];
#pragma unroll
        for (int d = 0; d < NDV; ++d) oacc[d] = mfma32(vf[d], pf[u][s2], oacc[d]);
      }
    }
    __syncthreads();
  }
  l += __shfl_xor(l, 32);
  const float linv = 1.f / l;
  {
    constexpr int SW = DV + 8;
    u16* st = (u16*)smem + w * (32 * SW);
#pragma unroll
    for (int d = 0; d < NDV; ++d)
#pragma unroll
      for (int g = 0; g < 4; ++g) {
        uint2 o;
        o.x = pack2(oacc[d][4 * g] * linv, oacc[d][4 * g + 1] * linv);
        o.y = pack2(oacc[d][4 * g + 2] * linv, oacc[d][4 * g + 3] * linv);
        *(uint2*)&st[r * SW + d * 32 + 8 * g + 4 * h] = o;
      }
    const size_t Rw = (size_t)b * TB + (isctx ? 0 : 256) + qb * 256 + w * 32;
#pragma unroll
    for (int j = 0; j < DV / 16; ++j) {
      const int chunk = j * 64 + lane, qq = chunk / (DV / 8), c8 = (chunk % (DV / 8)) * 8;
      const u32x4 ov = *(const u32x4*)&st[qq * SW + c8];
      const u32x4 gv = *(const u32x4*)(a.P + (Rw + qq) * LDP + GOFF + head * DV + c8);
      u32x4 rv;
#pragma unroll
      for (int q = 0; q < 4; ++q) {
        const float o0 = bf2f((u16)(ov[q] & 0xffff)), o1 = bf2f((u16)(ov[q] >> 16));
        const float g0 = bf2f((u16)(gv[q] & 0xffff)), g1 = bf2f((u16)(gv[q] >> 16));
        rv[q] = pack2(o0 * siluf(g0), o1 * siluf(g1));
      }
      *(u32x4*)(a.O + (Rw + qq) * 1024 + head * DV + c8) = rv;
    }
  }
}

template <int MODE>
DI void attn_phase(const AttnArgs& a, char* smem) {
  constexpr int H = MODE == 0 ? 8 : 16;
  const int NL = NB * H * 8;
  if (gridDim.x == 256) {
    const int x = blockIdx.x & 7, slot = blockIdx.x >> 3;
    const int grp = slot >> 3, qb = slot & 7;
    if (MODE == 0) {
      for (int it = 0; it < 8; ++it) { const int pair = (it * 4 + grp) * 8 + x; attn_unit<MODE>(a, pair >> 3, pair & 7, qb, false, smem); }
    } else {
      for (int it = 0; it < 16; ++it) { const int pair = it * 8 + x; attn_unit<MODE>(a, pair >> 2, (pair & 3) * 4 + grp, qb, false, smem); }
    }
  } else {
    for (int u = blockIdx.x; u < NL; u += gridDim.x) attn_unit<MODE>(a, u / (H * 8), (u >> 3) % H, u & 7, false, smem);
  }
  if (a.with_ctx) {
    const int NC = NB * H;
    for (int u = blockIdx.x; u < NC; u += gridDim.x) attn_unit<MODE>(a, u / H, u % H, 0, true, smem);
  }
}

DI void shortconv_phase(const Params& p, u16* PT) {
  const int tid0 = get_tid(); const int lane = tid0 & 63, w = tid0 >> 6;
  const int nitems = 3072 * NB * 2;
  for (int it = blockIdx.x * NW + w; it < nitems; it += gridDim.x * NW) {
    const int ch = it / (NB * 2), rem = it % (NB * 2), b = rem >> 1, isctx = rem & 1;
    const float w0 = p.c_conv_w[ch], w1 = p.c_conv_w[3072 + ch], w2 = p.c_conv_w[6144 + ch], cb = p.c_conv_b[ch];
    u16* base = PT + (size_t)ch * ROWS + (size_t)b * TB + (isctx ? 0 : 256);
    if (!isctx) {
      u32x4 q[4];
#pragma unroll
      for (int k = 0; k < 4; ++k) q[k] = *(const u32x4*)(base + (k * 64 + lane) * 8);
      float first[4], last[4];
#pragma unroll
      for (int k = 0; k < 4; ++k) { first[k] = bf2f((u16)(q[k][0] & 0xffff)); last[k] = bf2f((u16)(q[k][3] >> 16)); }
#pragma unroll
      for (int k = 0; k < 4; ++k) {
        float v[10];
#pragma unroll
        for (int e = 0; e < 4; ++e) { v[1 + 2 * e] = bf2f((u16)(q[k][e] & 0xffff)); v[2 + 2 * e] = bf2f((u16)(q[k][e] >> 16)); }
        const float lsame = __shfl_up(last[k], 1), rsame = __shfl_down(first[k], 1);
        const float lprev = (k > 0) ? __shfl(last[k > 0 ? k - 1 : 0], 63) : 0.f;
        const float rnext = (k < 3) ? __shfl(first[k < 3 ? k + 1 : 3], 0) : 0.f;
        v[0] = lane == 0 ? lprev : lsame;
        v[9] = lane == 63 ? rnext : rsame;
        u32x4 o;
#pragma unroll
        for (int e = 0; e < 4; ++e) {
          const int s2 = 2 * e;
          const float y0 = cb + w0 * v[s2] + w1 * v[s2 + 1] + w2 * v[s2 + 2];
          const float y1 = cb + w0 * v[s2 + 1] + w1 * v[s2 + 2] + w2 * v[s2 + 3];
          o[e] = pack2(y0, y1);
        }
        *(u32x4*)(base + (k * 64 + lane) * 8) = o;
      }
    } else {
      float v[6];
      uint2 q = *(const uint2*)(base + lane * 4);
      v[1] = bf2f((u16)(q.x & 0xffff)); v[2] = bf2f((u16)(q.x >> 16)); v[3] = bf2f((u16)(q.y & 0xffff)); v[4] = bf2f((u16)(q.y >> 16));
      float lft = __shfl_up(v[4], 1), rgt = __shfl_down(v[1], 1);
      v[0] = lane == 0 ? 0.f : lft;
      v[5] = lane == 63 ? 0.f : rgt;
      uint2 o;
      o.x = pack2(cb + w0 * v[0] + w1 * v[1] + w2 * v[2], cb + w0 * v[1] + w1 * v[2] + w2 * v[3]);
      o.y = pack2(cb + w0 * v[2] + w1 * v[3] + w2 * v[4], cb + w0 * v[3] + w1 * v[4] + w2 * v[5]);
      *(uint2*)(base + lane * 4) = o;
    }
  }
}

template <int MT>
DI void conv_unit(const u16* __restrict__ usrc, const u16* __restrict__ gsrc, const u16* __restrict__ gatesrc,
                  u16* __restrict__ dst, const float* __restrict__ hf, const float* __restrict__ hb, float bias,
                  int n, int tok0, int t_lo, char* smem) {
  constexpr int MROWS = MT * 256;
  const int FL = n + MROWS, FLP = FL + 16;
  const int OFF = t_lo + MROWS;
  u16* fc = (u16*)smem;
  u16* Us = fc + 8 * 3088;
  const int tid = get_tid(), lane = tid & 63, w = tid >> 6, r = lane & 31, h = lane >> 5;
  __syncthreads();
  {
    const int FL8 = FL >> 3;
    for (int idx = tid; idx < 8 * FL8; idx += NT) {
      const int sg = idx / FL8, p8 = (idx - sg * FL8) * 8;
      const int lag0 = sg + OFF - p8;
      float v[8];
#pragma unroll
      for (int j = 0; j < 8; ++j) {
        const int lag = lag0 - j;
        float x = 0.f;
        if (lag > 0) { if (lag < n) x = hf[lag]; }
        else if (lag < 0) { if (lag > -n) x = hb[-lag]; }
        else x = hf[0] + hb[0];
        v[j] = x;
      }
      u32x4 o; o[0] = pack2(v[0], v[1]); o[1] = pack2(v[2], v[3]); o[2] = pack2(v[4], v[5]); o[3] = pack2(v[6], v[7]);
      *(u32x4*)&fc[sg * FLP + p8] = o;
    }
  }
  f32x16 acc[MT];
#pragma unroll
  for (int mi = 0; mi < MT; ++mi) acc[mi] = zero16();
  const int nchunks = n / 256;
  const int abase = (r & 7) * FLP + 8 * h - 8 * (r >> 3) + OFF;
  const int ub = tid >> 4, usc = (tid & 15) * 8;
  const u16* up = usrc + (size_t)ub * TB + tok0 + usc;
  u16* ud = Us + ub * 264 + usc;
  u32x4 ureg[2];
#pragma unroll
  for (int i = 0; i < 2; ++i) ureg[i] = *(const u32x4*)(up + 128 * i);
  constexpr int USTAGE = 32 * 264;
  __syncthreads();
#pragma unroll
  for (int i = 0; i < 2; ++i) *(u32x4*)(ud + 128 * i) = ureg[i];
  __syncthreads();
  {
    const int nc = min(1, nchunks - 1);
#pragma unroll
    for (int i = 0; i < 2; ++i) ureg[i] = *(const u32x4*)(up + nc * 256 + 128 * i);
  }
#pragma unroll 1
  for (int ch = 0; ch < nchunks; ++ch) {
    const int cur = ch & 1;
#pragma unroll
    for (int i = 0; i < 2; ++i) *(u32x4*)(ud + (cur ^ 1) * USTAGE + 128 * i) = ureg[i];
    {
      const int nc = min(ch + 2, nchunks - 1);
#pragma unroll
      for (int i = 0; i < 2; ++i) ureg[i] = *(const u32x4*)(up + nc * 256 + 128 * i);
    }
    __builtin_amdgcn_sched_barrier(0);
    {
      const u16* bp_ = &Us[cur * USTAGE + r * 264 + 8 * h];
      const u16* ap_ = &fc[abase + ch * 256 - t_lo - w * MT * 32];
      bf16x8 bcur = *(const bf16x8*)bp_, acur[MT];
#pragma unroll
      for (int mi = 0; mi < MT; ++mi) acur[mi] = *(const bf16x8*)(ap_ - mi * 32);
#pragma unroll 4
      for (int kbl = 0; kbl < 16; ++kbl) {
        const int kn = min(kbl + 1, 15);
        bf16x8 bnxt = *(const bf16x8*)(bp_ + 16 * kn), anxt[MT];
#pragma unroll
        for (int mi = 0; mi < MT; ++mi) anxt[mi] = *(const bf16x8*)(ap_ + 16 * kn - mi * 32);
#pragma unroll
        for (int mi = 0; mi < MT; ++mi) acc[mi] = mfma32(acur[mi], bcur, acc[mi]);
        bcur = bnxt;
#pragma unroll
        for (int mi = 0; mi < MT; ++mi) acur[mi] = anxt[mi];
      }
    }
    __builtin_amdgcn_sched_barrier(0);
    __syncthreads();
  }
  {
    constexpr int SW = MT * 32 + 8;
    u16* st = (u16*)smem + w * (32 * SW);
#pragma unroll
    for (int mi = 0; mi < MT; ++mi)
#pragma unroll
      for (int g = 0; g < 4; ++g) {
        uint2 o;
        o.x = pack2(acc[mi][4 * g], acc[mi][4 * g + 1]);
        o.y = pack2(acc[mi][4 * g + 2], acc[mi][4 * g + 3]);
        *(uint2*)&st[r * SW + mi * 32 + 8 * g + 4 * h] = o;
      }
    const int tw = t_lo + w * MT * 32;
#pragma unroll
    for (int j = 0; j < MT * 2; ++j) {
      const int chunk = j * 64 + lane, bb = chunk / (MT * 4), t8 = (chunk % (MT * 4)) * 8;
      const u32x4 yv = *(const u32x4*)&st[bb * SW + t8];
      const size_t off = (size_t)bb * TB + tok0 + tw + t8;
      const u32x4 uv = *(const u32x4*)(usrc + off), gv = *(const u32x4*)(gsrc + off);
      u32x4 tv = uv;
      if (gatesrc) tv = *(const u32x4*)(gatesrc + off);
      u32x4 ov;
#pragma unroll
      for (int q = 0; q < 4; ++q) {
        const float y0 = bf2f((u16)(yv[q] & 0xffff)), y1 = bf2f((u16)(yv[q] >> 16));
        const float u0 = bf2f((u16)(uv[q] & 0xffff)), u1 = bf2f((u16)(uv[q] >> 16));
        const float g0 = bf2f((u16)(gv[q] & 0xffff)), g1 = bf2f((u16)(gv[q] >> 16));
        float z0 = g0 * (y0 + u0 * bias), z1 = g1 * (y1 + u1 * bias);
        if (gatesrc) { z0 *= siluf(bf2f((u16)(tv[q] & 0xffff))); z1 *= siluf(bf2f((u16)(tv[q] >> 16))); }
        ov[q] = pack2(z0, z1);
      }
      *(u32x4*)(dst + off) = ov;
    }
  }
}

DI void conv_phase(const Params& p, int o, const u16* PT, const u16* Uin, u16* dstT, char* smem) {
  const int nunits = 2048 + 1024;
  for (int u0 = blockIdx.x; u0 < nunits; u0 += gridDim.x) {
    int u = u0;
    if ((gridDim.x & 7) == 0 && u0 < 2048) {
      const int x = u0 & 7, li = u0 >> 3;
      u = (((li >> 1) * 8 + x) << 1) | (li & 1);
    }
    const bool isctx = u >= 2048;
    const int c = isctx ? (u - 2048) : (u >> 1);
    const u16* usrc = Uin + (size_t)c * ROWS;
    const u16* gsrc = PT + (size_t)(1024 * (1 + o) + c) * ROWS;
    const u16* gatesrc = o == 1 ? PT + (size_t)(3072 + c) * ROWS : nullptr;
    u16* dst = dstT + (size_t)c * ROWS;
    const float bias = p.c_filt_bias[o * 1024 + c];
    if (!isctx) {
      const float* hf = p.filt + (size_t)((0 * 2 + o) * 1024 + c) * 2048;
      const float* hb = p.filt + (size_t)((1 * 2 + o) * 1024 + c) * 2048;
      conv_unit<4>(usrc, gsrc, gatesrc, dst, hf, hb, bias, 2048, 256, (u & 1) * 1024, smem);
    } else {
      const float* fb = p.filt + (size_t)4096 * 2048;
      const float* hf = fb + (size_t)((0 * 2 + o) * 1024 + c) * 256;
      const float* hb = fb + (size_t)((1 * 2 + o) * 1024 + c) * 256;
      conv_unit<1>(usrc, gsrc, gatesrc, dst, hf, hb, bias, 256, 0, 0, smem);
    }
  }
}

DI void transpose_phase(const u16* __restrict__ src, u16* __restrict__ dst, char* smem) {
  u16* tl = (u16*)smem;
  const int tid = get_tid();
  const int ntiles = 16 * (ROWS / 64);
  for (int t = blockIdx.x; t < ntiles; t += gridDim.x) {
    const int tc = t & 15, tr = t >> 4, c0 = tc * 64, r0 = tr * 64;
    __syncthreads();
    {
      int cidx = tid, cl = cidx >> 3, q = (cidx & 7) * 8;
      uint4 v = *(const uint4*)(src + (size_t)(c0 + cl) * ROWS + r0 + q);
      unsigned* d = (unsigned*)&tl[cl * 66 + q];
      d[0] = v.x; d[1] = v.y; d[2] = v.z; d[3] = v.w;
    }
    __syncthreads();
    {
      int cidx = tid, tk = cidx >> 3, q = (cidx & 7) * 8;
      unsigned o[4];
#pragma unroll
      for (int e = 0; e < 4; ++e) o[e] = (unsigned)tl[(q + 2 * e) * 66 + tk] | ((unsigned)tl[(q + 2 * e + 1) * 66 + tk] << 16);
      uint4 v; v.x = o[0]; v.y = o[1]; v.z = o[2]; v.w = o[3];
      *(uint4*)(dst + (size_t)(r0 + tk) * 1024 + c0 + q) = v;
    }
  }
}

DI void mla_layer(const Params& p, const XcdBarrier& xb, int j, bool with_ctx, char* smem) {
  u16* P = p.BIG;
  u16* Q = P + (size_t)ROWS * 1856;
  u16* KN = Q + (size_t)ROWS * 1536;
  u16* VT = KN + (size_t)ROWS * 1024;
  Epi e{}; e.cosT = p.cosT; e.sinT = p.sinT;
  e.mode = E_MLA_IN; e.C = P; e.ldc = 1856;
  gemm_phase(p.R0, 1024, p.aWin + (size_t)j * 1856 * 1024, 1024, 1856, 1024, e, false, smem);
  xcd_barrier(xb);
  e.mode = E_MLA_Q; e.C = Q; e.ldc = 1536;
  gemm_phase(P, 1856, p.aWq + (size_t)j * 1536 * 512, 512, 1536, 512, e, true, smem);
  e.mode = E_MLA_KV; e.C = KN; e.ldc = 1024; e.C2 = VT;
  gemm_phase(P + 512, 1856, p.aWkv + (size_t)j * 2048 * 256, 256, 2048, 256, e, true, smem);
  xcd_barrier(xb);
  AttnArgs a{}; a.Q = Q; a.P = P; a.KN = KN; a.VT = VT; a.O = p.R0; a.sink = nullptr; a.with_ctx = with_ctx ? 1 : 0;
  attn_phase<0>(a, smem);
  xcd_barrier(xb);
  e.mode = E_PLAIN; e.C = Q; e.ldc = 1024;
  gemm_phase(p.R0, 1024, p.aWout + (size_t)j * 1024 * 1024, 1024, 1024, 1024, e, false, smem);
  xcd_barrier(xb);
}

__global__ void __launch_bounds__(512, 2) mega(Params p) {
  extern __shared__ __attribute__((aligned(16))) char smem[];
  __shared__ uint4 xb_words;
  if (threadIdx.x == 0) xb_words = make_uint4(0u, 0u, 0u, 0u);
  __syncthreads();
  const XcdBarrier xb = xcd_barrier_post(p.bar, (volatile LAS unsigned*)&xb_words);
  if (p.out == nullptr) cg::this_grid().sync();
  {
    const int NMOD = 192, NTR = 4256, NROPE = 128, NF1 = 288;
    const int nitems = NMOD + NTR + NROPE + NF1;
    for (int it = blockIdx.x; it < nitems; it += gridDim.x) {
      if (it < NMOD) mod_item(p, it, (float*)smem);
      else if (it < NMOD + NTR) {
        int t = it - NMOD;
        float* sm = (float*)smem;
        if (t < 928) { int j = t / 464; transpose_tile(p.a_w_in + (size_t)j * 1024 * 1856, p.aWin + (size_t)j * 1856 * 1024, 1024, 1856, nullptr, t % 464, sm); }
        else if ((t -= 928) < 384) { int j = t / 192; transpose_tile(p.a_w_q + (size_t)j * 512 * 1536, p.aWq + (size_t)j * 1536 * 512, 512, 1536, p.a_g_q + j * 512, t % 192, sm); }
        else if ((t -= 384) < 256) { int j = t / 128; transpose_tile(p.a_w_kv + (size_t)j * 256 * 2048, p.aWkv + (size_t)j * 2048 * 256, 256, 2048, p.a_g_kv + j * 256, t % 128, sm); }
        else if ((t -= 256) < 512) { int j = t / 256; transpose_tile(p.a_w_out + (size_t)j * 1024 * 1024, p.aWout + (size_t)j * 1024 * 1024, 1024, 1024, nullptr, t % 256, sm); }
        else if ((t -= 512) < 640) transpose_tile(p.b_w_in, p.bWin, 1024, 2560, nullptr, t, sm);
        else if ((t -= 640) < 256) transpose_tile(p.b_w_out, p.bWout, 1024, 1024, nullptr, t, sm);
        else if ((t -= 256) < 1024) transpose_tile(p.c_w_in, p.cWin, 1024, 4096, nullptr, t, sm);
        else { t -= 1024; transpose_tile(p.c_w_out, p.cWout, 1024, 1024, nullptr, t, sm); }
      }
      else if (it < NMOD + NTR + NROPE) rope_item(p, it - NMOD - NTR);
      else f1_item(p, it - NMOD - NTR - NROPE);
    }
  }
  xcd_barrier(xb);
  rowwise_phase(p, 0, nullptr);
  for (int it = blockIdx.x; it < 2048 * 9; it += gridDim.x) f2_item(p, it);
  xcd_barrier(xb);
  mla_layer(p, xb, 0, true, smem);
  rowwise_phase(p, 1, p.BIG + (size_t)ROWS * 1856);
  xcd_barrier(xb);
  {
    u16* P = p.BIG;
    u16* VT = P + (size_t)ROWS * 2560;
    u16* Y = VT + (size_t)NB * 4 * 64 * TB;
    Epi e{}; e.cosT = p.cosT; e.sinT = p.sinT;
    e.mode = E_SWA_IN; e.C = P; e.ldc = 2560; e.C2 = VT;
    gemm_phase(p.R0, 1024, p.bWin, 1024, 2560, 1024, e, false, smem);
    xcd_barrier(xb);
    AttnArgs a{}; a.Q = P; a.P = P; a.KN = nullptr; a.VT = VT; a.O = p.R0; a.sink = p.b_sink; a.with_ctx = 1;
    attn_phase<1>(a, smem);
    xcd_barrier(xb);
    e.mode = E_PLAIN; e.C = Y; e.ldc = 1024;
    gemm_phase(p.R0, 1024, p.bWout, 1024, 1024, 1024, e, false, smem);
    xcd_barrier(xb);
    rowwise_phase(p, 2, Y);
    xcd_barrier(xb);
  }
  {
    u16* PT = p.BIG;
    u16* Z = PT + (size_t)4096 * ROWS;
    Epi e{}; e.mode = E_TRANS; e.C = PT;
    gemm_phase(p.R0, 1024, p.cWin, 1024, 4096, 1024, e, false, smem);
    xcd_barrier(xb);
    shortconv_phase(p, PT);
    xcd_barrier(xb);
    conv_phase(p, 0, PT, PT, Z, smem);
    xcd_barrier(xb);
    conv_phase(p, 1, PT, Z, p.R0, smem);
    xcd_barrier(xb);
    transpose_phase(p.R0, Z, smem);
    xcd_barrier(xb);
    e.mode = E_PLAIN; e.C = p.R0; e.ldc = 1024;
    gemm_phase(Z, 1024, p.cWout, 1024, 1024, 1024, e, false, smem);
    xcd_barrier(xb);
    rowwise_phase(p, 3, p.R0);
    xcd_barrier(xb);
  }
  mla_layer(p, xb, 1, false, smem);
  rowwise_phase(p, 4, p.BIG + (size_t)ROWS * 1856);
}

extern "C" void kernel_launch(void* const* d_in, const int* in_sizes, int n_in,
                              void* d_out, int out_size, void* d_ws, size_t ws_size,
                              hipStream_t stream) {
  static int grid_blocks = 0;
  if (!grid_blocks) {
    int dev = 0, cus = 0, per_cu = 0;
    (void)hipGetDevice(&dev);
    (void)hipDeviceGetAttribute(&cus, hipDeviceAttributeMultiprocessorCount, dev);
    (void)hipFuncSetAttribute((const void*)mega, hipFuncAttributeMaxDynamicSharedMemorySize, SMEM_BYTES);
    (void)hipOccupancyMaxActiveBlocksPerMultiprocessor(&per_cu, mega, NT, SMEM_BYTES);
    if (per_cu > 1) per_cu = 1;
    if (per_cu < 1) per_cu = 1;
    grid_blocks = cus * per_cu;
  }
  Params p{};
  const float* const* in = (const float* const*)d_in;
  p.x = in[0]; p.c = in[1]; p.ctx = in[2]; p.c_ctx = in[3]; p.w_mod = in[4]; p.b_mod = in[5]; p.g_pre = in[6]; p.g_post = in[7];
  p.a_w_in = in[8]; p.a_g_q = in[9]; p.a_w_q = in[10]; p.a_g_kv = in[11]; p.a_w_kv = in[12]; p.a_w_out = in[13];
  p.b_w_in = in[14]; p.b_sink = in[15]; p.b_w_out = in[16];
  p.c_w_in = in[17]; p.c_conv_w = in[18]; p.c_conv_b = in[19]; p.c_f_w1 = in[20]; p.c_f_b1 = in[21]; p.c_f_freq = in[22];
  p.c_f_w2 = in[23]; p.c_f_b2 = in[24]; p.c_f_w3 = in[25]; p.c_filt_bias = in[26]; p.c_w_out = in[27];
  p.out = (float*)d_out;
  char* ws = (char*)d_ws;
  size_t off = 0;
  auto take = [&](size_t bytes) { char* q = ws + off; off += (bytes + 255) & ~(size_t)255; return q; };
  p.aWin = (u16*)take((size_t)2 * 1856 * 1024 * 2);
  p.aWq = (u16*)take((size_t)2 * 1536 * 512 * 2);
  p.aWkv = (u16*)take((size_t)2 * 2048 * 256 * 2);
  p.aWout = (u16*)take((size_t)2 * 1024 * 1024 * 2);
  p.bWin = (u16*)take((size_t)2560 * 1024 * 2);
  p.bWout = (u16*)take((size_t)1024 * 1024 * 2);
  p.cWin = (u16*)take((size_t)4096 * 1024 * 2);
  p.cWout = (u16*)take((size_t)1024 * 1024 * 2);
  p.mod = (float*)take((size_t)4 * 33 * 3072 * 4);
  p.cosT = (float*)take((size_t)2048 * 32 * 4);
  p.sinT = (float*)take((size_t)2048 * 32 * 4);
  p.h2 = (float*)take((size_t)2304 * 64 * 4);
  p.filt = (float*)take((size_t)2304 * 4096 * 4);
  p.ctxw = (float*)take((size_t)NB * 256 * 1024 * 4);
  p.R0 = (u16*)take((size_t)ROWS * 1024 * 2);
  p.BIG = (u16*)take((size_t)ROWS * (1856 + 1536 + 1024 + 1024) * 2);
  p.bar = (unsigned*)take((size_t)XCD_BAR_WORDS * 4);
  if (off > ws_size) { fprintf(stderr, "workspace too small: need %zu have %zu\n", off, ws_size); return; }
  (void)hipMemsetAsync(p.bar, 0, (size_t)XCD_BAR_WORDS * 4, stream);
  void* args[] = {&p};
  hipError_t e = hipLaunchCooperativeKernel((void*)mega, dim3(grid_blocks), dim3(NT), args, SMEM_BYTES, stream);
  if (e != hipSuccess) fprintf(stderr, "coop launch failed: %s (grid %d)\n", hipGetErrorString(e), grid_blocks);
}
```

```cpp
#include <hip/hip_runtime.h>
#include <hip/hip_cooperative_groups.h>
#include <cstdio>
#include <cmath>
namespace cg = cooperative_groups;

typedef unsigned short u16;
typedef __attribute__((ext_vector_type(8))) short bf16x8;
typedef __attribute__((ext_vector_type(16))) float f32x16;
typedef __attribute__((ext_vector_type(4))) unsigned u32x4;

#define DI __device__ __forceinline__
constexpr int NB = 32, TB = 2304, ROWS = NB * TB;
constexpr float EPS = 1e-6f;
constexpr float LOG2E = 1.4426950408889634f;
constexpr int SMEM_BYTES = 149504;
constexpr int NT = 512, NW = 8;

struct Params {
  const float *x, *c, *ctx, *c_ctx, *w_mod, *b_mod, *g_pre, *g_post;
  const float *a_w_in, *a_g_q, *a_w_q, *a_g_kv, *a_w_kv, *a_w_out;
  const float *b_w_in, *b_sink, *b_w_out;
  const float *c_w_in, *c_conv_w, *c_conv_b, *c_f_w1, *c_f_b1, *c_f_freq, *c_f_w2, *c_f_b2, *c_f_w3, *c_filt_bias, *c_w_out;
  float* out;
  u16 *aWin, *aWq, *aWkv, *aWout, *bWin, *bWout, *cWin, *cWout;
  float *mod, *cosT, *sinT, *h2, *filt, *ctxw;
  u16 *R0, *BIG;
  unsigned* bar;
};

typedef __attribute__((ext_vector_type(2))) __bf16 bf16v2;
typedef __attribute__((ext_vector_type(2))) float f32v2;
DI unsigned pack2(float a, float b) { f32v2 v = {a, b}; return __builtin_bit_cast(unsigned, __builtin_convertvector(v, bf16v2)); }
DI u16 f2bf(float x) { return (u16)(pack2(x, 0.f) & 0xffffu); }
DI float bf2f(u16 v) { return __uint_as_float(((unsigned)v) << 16); }
DI float siluf(float v) { return v * __builtin_amdgcn_rcpf(1.f + __expf(-v)); }
DI f32x16 mfma32(bf16x8 a, bf16x8 b, f32x16 c) { return __builtin_amdgcn_mfma_f32_32x32x16_bf16(a, b, c, 0, 0, 0); }
DI int get_tid() { int t = threadIdx.x; asm volatile("" : "+v"(t)); return t; }
DI f32x16 zero16() { f32x16 z; for (int i = 0; i < 16; ++i) z[i] = 0.f; return z; }


#define XB_TMO      128
#define XB_XCNT(j)  (256  + 64 * (j))
#define XB_XSUB(j)  (1280 + 64 * (j))
#define XB_XGEN(j)  (2304 + 64 * (j))
#define XB_TOP      3328
#define XB_TOPGEN   3392
#define XCD_BAR_WORDS 3456
#define XB_SPIN_CAP (1u << 20)
#define LAS __attribute__((address_space(3)))
DI unsigned xb_ld(unsigned* p)              { return __hip_atomic_load(p, __ATOMIC_RELAXED, __HIP_MEMORY_SCOPE_AGENT); }
DI unsigned xb_add(unsigned* p, unsigned v) { return __hip_atomic_fetch_add(p, v, __ATOMIC_RELAXED, __HIP_MEMORY_SCOPE_AGENT); }
DI unsigned xb_xcc_id() { return (unsigned)__builtin_amdgcn_s_getreg((3 << 11) | 20) & 0xFu; }
#define XB_SPIN(cond, bar) do { unsigned _sp = 0; while (cond) { __builtin_amdgcn_s_sleep(1); \
    if ((++_sp & 255u) == 0u) { if (xb_ld(&(bar)[XB_TMO])) break; if (_sp > XB_SPIN_CAP) { atomicAdd(&(bar)[XB_TMO], 1u); break; } } } } while (0)
struct XcdBarrier { unsigned* bar; unsigned x; volatile LAS unsigned* st; };
DI XcdBarrier xcd_barrier_post(unsigned* bar, volatile LAS unsigned* st) {
  XcdBarrier b; b.bar = bar; b.x = xb_xcc_id(); b.st = st;
  if (threadIdx.x == 0) (void)xb_add(&bar[XB_XCNT(b.x)], 1u);
  return b;
}
DI void xcd_barrier_complete(unsigned* bar, unsigned x, unsigned& nloc, unsigned& nx) {
  const unsigned G = gridDim.x * gridDim.y * gridDim.z;
  unsigned sum, cnt, mine, sp = 0u;
  for (;;) {
    sum = 0u; cnt = 0u; mine = 0u;
#pragma unroll
    for (unsigned j = 0; j < 16; ++j) { const unsigned c = xb_ld(&bar[XB_XCNT(j)]); sum += c; cnt += (c > 0u) ? 1u : 0u; mine = (j == x) ? c : mine; }
    if (sum == G) break;
    __builtin_amdgcn_s_sleep(1);
    if ((++sp & 255u) == 0u) { if (xb_ld(&bar[XB_TMO])) break; if (sp > XB_SPIN_CAP) { atomicAdd(&bar[XB_TMO], 1u); break; } }
  }
  nloc = mine > 0u ? mine : 1u; nx = cnt > 0u ? cnt : 1u;
}
DI void xcd_barrier(const XcdBarrier& b) {
  asm volatile("s_waitcnt vmcnt(0)" ::: "memory");
  __syncthreads();
  if (threadIdx.x == 0) {
    unsigned* bar = b.bar;
    __builtin_amdgcn_s_waitcnt(0);
    unsigned nloc = b.st[0], nx = b.st[1];
    if (nloc == 0u) { xcd_barrier_complete(bar, b.x, nloc, nx); b.st[0] = nloc; b.st[1] = nx; }
    const unsigned old = xb_add(&bar[XB_XSUB(b.x)], 1u);
    const unsigned gen = old / nloc;
    if (old + 1u == (gen + 1u) * nloc) {
      __builtin_amdgcn_fence(__ATOMIC_RELEASE, "agent");
      asm volatile("s_waitcnt vmcnt(0)" ::: "memory");
      const unsigned og = xb_add(&bar[XB_TOP], 1u);
      const unsigned tg = og / nx;
      if (og + 1u == (tg + 1u) * nx) xb_add(&bar[XB_TOPGEN], 1u);
      else XB_SPIN(xb_ld(&bar[XB_TOPGEN]) == tg, bar);
      __builtin_amdgcn_fence(__ATOMIC_ACQUIRE, "agent");
      xb_add(&bar[XB_XGEN(b.x)], 1u);
      asm volatile("s_waitcnt vmcnt(0)" ::: "memory");
    } else {
      XB_SPIN(xb_ld(&bar[XB_XGEN(b.x)]) == gen, bar);
      __builtin_amdgcn_fence(__ATOMIC_ACQUIRE, "agent");
      asm volatile("s_waitcnt vmcnt(0)" ::: "memory");
    }
  }
  __syncthreads();
}

DI void transpose_tile(const float* __restrict__ W, u16* __restrict__ Wt, int K, int N, const float* __restrict__ gain,
                       int tile, float* sm) {
  const int ntn = N / 64, tk = tile / ntn, tn = tile % ntn, k0 = tk * 64, n0 = tn * 64, tid = threadIdx.x;
  for (int i = 0; i < 8; ++i) {
    int kk = (tid >> 6) + 8 * i, nn = tid & 63;
    float v = W[(size_t)(k0 + kk) * N + n0 + nn];
    if (gain) v *= gain[k0 + kk];
    sm[nn * 65 + kk] = v;
  }
  __syncthreads();
  for (int i = 0; i < 8; ++i) {
    int nn = (tid >> 6) + 8 * i, kk = tid & 63;
    Wt[(size_t)(n0 + nn) * K + k0 + kk] = f2bf(sm[nn * 65 + kk]);
  }
  __syncthreads();
}

DI void mod_item(const Params& p, int it, float* sm) {
  const int tid = get_tid(), col = tid & 63, kg = tid >> 6;
  const int l = it / 48, j = (it % 48) * 64 + col;
  float* sc = sm + kg * (33 * 64);
  float acc[33];
#pragma unroll
  for (int r = 0; r < 33; ++r) acc[r] = 0.f;
  __syncthreads();
  for (int k0 = kg * 128; k0 < kg * 128 + 128; k0 += 64) {
    for (int idx = col; idx < 33 * 64; idx += 64) {
      int r = idx >> 6, kk = idx & 63;
      float cv = (r < 32) ? p.c[r * 1024 + k0 + kk] : p.c_ctx[k0 + kk];
      sc[idx] = cv / (1.f + expf(-cv));
    }
    __syncthreads();
    for (int kk = 0; kk < 64; kk += 4) {
      float w0 = p.w_mod[((size_t)l * 1024 + k0 + kk) * 3072 + j];
      float w1 = p.w_mod[((size_t)l * 1024 + k0 + kk + 1) * 3072 + j];
      float w2 = p.w_mod[((size_t)l * 1024 + k0 + kk + 2) * 3072 + j];
      float w3 = p.w_mod[((size_t)l * 1024 + k0 + kk + 3) * 3072 + j];
#pragma unroll
      for (int r = 0; r < 33; ++r) {
        float4 s4 = *(const float4*)&sc[r * 64 + kk];
        acc[r] += s4.x * w0 + s4.y * w1 + s4.z * w2 + s4.w * w3;
      }
    }
    __syncthreads();
  }
  float* red = sm;
#pragma unroll
  for (int r = 0; r < 33; ++r) red[(kg * 33 + r) * 64 + col] = acc[r];
  __syncthreads();
  const float bm = p.b_mod[l * 3072 + j];
  for (int r = kg; r < 33; r += 8) {
    float t = 0.f;
#pragma unroll
    for (int g = 0; g < 8; ++g) t += red[(g * 33 + r) * 64 + col];
    p.mod[((size_t)l * 33 + r) * 3072 + j] = t + bm;
  }
  __syncthreads();
}

DI void rope_item(const Params& p, int it) {
  int idx = it * 512 + threadIdx.x;
  int pos = idx >> 5, a = idx & 31, i = a & 15;
  float inv = powf(10000.f, -(float)(2 * i) / 32.f);
  float v = (float)((a < 16) ? (pos >> 6) : (pos & 63)) * inv;
  p.cosT[idx] = cosf(v);
  p.sinT[idx] = sinf(v);
}

DI void f1_item(const Params& p, int it) {
  const int w = threadIdx.x >> 6, j = threadIdx.x & 63;
  const int pidx = it * 8 + w;
  const int n = pidx < 2048 ? 2048 : 256, t = pidx < 2048 ? pidx : pidx - 2048;
  const float tl = (float)t / (float)(n - 1);
  const float wv = (n == 2048 ? (float)(2.0 * M_PI / 2048.0) : (float)(2.0 * M_PI / 256.0)) * (float)t;
  const float bstep = (15.f - 1e-4f) / 15.f;
  float z = 0.f;
  if (j == 0) z = tl;
  else if (j <= 16) z = cosf((1e-4f + (float)(j - 1) * bstep) * wv);
  else if (j <= 32) z = -sinf((1e-4f + (float)(j - 17) * bstep) * wv);
  const float fr = p.c_f_freq[j];
  float h1 = p.c_f_b1[j];
  for (int k = 0; k < 33; ++k) h1 += __shfl(z, k) * p.c_f_w1[k * 64 + j];
  h1 = sinf(fr * h1);
  float h2 = p.c_f_b2[j];
  for (int k = 0; k < 64; ++k) h2 += __shfl(h1, k) * p.c_f_w2[k * 64 + j];
  h2 = sinf(fr * h2);
  p.h2[pidx * 64 + j] = h2;
}

DI void f2_item(const Params& p, int it) {
  const int col = (it / 9) * 2 + (threadIdx.x >> 8), tc = it % 9, tid = threadIdx.x & 255;
  const int pidx = tc * 256 + tid;
  const int n = tc < 8 ? 2048 : 256, t = tc < 8 ? pidx : tid;
  const float4* hp = (const float4*)(p.h2 + (size_t)pidx * 64);
  float acc = 0.f;
  for (int q = 0; q < 16; ++q) {
    float4 hv = hp[q];
    acc += hv.x * p.c_f_w3[(q * 4 + 0) * 4096 + col];
    acc += hv.y * p.c_f_w3[(q * 4 + 1) * 4096 + col];
    acc += hv.z * p.c_f_w3[(q * 4 + 2) * 4096 + col];
    acc += hv.w * p.c_f_w3[(q * 4 + 3) * 4096 + col];
  }
  const int c = col & 1023;
  const float dmin = logf(0.01f) / 1.5f, dmax = logf(0.01f) / 0.3f;
  const float delta = fabsf(dmin + (float)c * ((dmax - dmin) / 1023.f));
  const float tl = (float)t / (float)(n - 1);
  float v = acc * expf(-tl * delta);
  if (tc < 8) p.filt[(size_t)col * 2048 + t] = v;
  else p.filt[(size_t)4096 * 2048 + (size_t)col * 256 + t] = v;
}

DI float wave_sum(float v) {
  for (int o = 32; o >= 1; o >>= 1) v += __shfl_xor(v, o);
  return v;
}

DI void rowwise_phase(const Params& p, int l, const u16* __restrict__ Y, float* dlat = nullptr, float* dctx = nullptr, u16* dh = nullptr) {
  const int tid0 = get_tid(); const int lane = tid0 & 63, w = tid0 >> 6;
  for (int R = blockIdx.x * NW + w; R < ROWS; R += gridDim.x * NW) {
    const int b = R / TB, i = R % TB;
    const bool isctx = i < 256;
    if (isctx && l == 4) continue;
    const int mr = isctx ? 32 : b;
    float* xres = isctx ? p.ctxw + ((size_t)b * 256 + i) * 1024 : p.out + ((size_t)b * 2048 + (i - 256)) * 1024;
    const float* xin = (l == 0) ? (isctx ? p.ctx + ((size_t)b * 256 + i) * 1024 : p.x + ((size_t)b * 2048 + (i - 256)) * 1024) : xres;
    float xv[16];
#pragma unroll
    for (int k = 0; k < 4; ++k) {
      float4 v = *(const float4*)(xin + k * 256 + lane * 4);
      xv[4 * k] = v.x; xv[4 * k + 1] = v.y; xv[4 * k + 2] = v.z; xv[4 * k + 3] = v.w;
    }
    if (l > 0) {
      float yv[16], ss = 0.f;
#pragma unroll
      for (int k = 0; k < 4; ++k) {
        uint2 v = *(const uint2*)(Y + (size_t)R * 1024 + k * 256 + lane * 4);
        yv[4 * k] = bf2f((u16)(v.x & 0xffff)); yv[4 * k + 1] = bf2f((u16)(v.x >> 16));
        yv[4 * k + 2] = bf2f((u16)(v.y & 0xffff)); yv[4 * k + 3] = bf2f((u16)(v.y >> 16));
      }
#pragma unroll
      for (int e = 0; e < 16; ++e) ss += yv[e] * yv[e];
      ss = wave_sum(ss);
      const float rinv = rsqrtf(ss * (1.f / 1024.f) + EPS);
      const float* gp = p.g_post + (l - 1) * 1024;
      const float* gt = p.mod + ((size_t)(l - 1) * 33 + mr) * 3072 + 2048;
#pragma unroll
      for (int k = 0; k < 4; ++k) {
        float4 g4 = *(const float4*)(gp + k * 256 + lane * 4);
        float4 t4 = *(const float4*)(gt + k * 256 + lane * 4);
        xv[4 * k] += t4.x * (yv[4 * k] * rinv * g4.x);
        xv[4 * k + 1] += t4.y * (yv[4 * k + 1] * rinv * g4.y);
        xv[4 * k + 2] += t4.z * (yv[4 * k + 2] * rinv * g4.z);
        xv[4 * k + 3] += t4.w * (yv[4 * k + 3] * rinv * g4.w);
      }
    }
    float* xdst = xres;
    if (dlat) xdst = isctx ? dctx + ((size_t)b * 256 + i) * 1024 : dlat + ((size_t)b * 2048 + (i - 256)) * 1024;
#pragma unroll
    for (int k = 0; k < 4; ++k) {
      float4 v; v.x = xv[4 * k]; v.y = xv[4 * k + 1]; v.z = xv[4 * k + 2]; v.w = xv[4 * k + 3];
      *(float4*)(xdst + k * 256 + lane * 4) = v;
    }
    if (l < 4) {
      float ss = 0.f;
#pragma unroll
      for (int e = 0; e < 16; ++e) ss += xv[e] * xv[e];
      ss = wave_sum(ss);
      const float rinv = rsqrtf(ss * (1.f / 1024.f) + EPS);
      const float* gp = p.g_pre + l * 1024;
      const float* md = p.mod + ((size_t)l * 33 + mr) * 3072;
#pragma unroll
      for (int k = 0; k < 4; ++k) {
        float4 g4 = *(const float4*)(gp + k * 256 + lane * 4);
        float4 sh = *(const float4*)(md + k * 256 + lane * 4);
        float4 sc = *(const float4*)(md + 1024 + k * 256 + lane * 4);
        float h0 = xv[4 * k] * rinv * g4.x * (1.f + sc.x) + sh.x;
        float h1 = xv[4 * k + 1] * rinv * g4.y * (1.f + sc.y) + sh.y;
        float h2 = xv[4 * k + 2] * rinv * g4.z * (1.f + sc.z) + sh.z;
        float h3 = xv[4 * k + 3] * rinv * g4.w * (1.f + sc.w) + sh.w;
        uint2 o; o.x = pack2(h0, h1); o.y = pack2(h2, h3);
        *(uint2*)((dh ? dh : p.R0) + (size_t)R * 1024 + k * 256 + lane * 4) = o;
      }
    }
  }
}

enum { E_PLAIN = 0, E_MLA_IN, E_MLA_Q, E_MLA_KV, E_SWA_IN, E_TRANS };
struct Epi { int mode; u16* C; int ldc; u16* C2; const float* cosT; const float* sinT; };

DI void store_plain(u16* __restrict__ C, int ldc, int row0, int col0, const f32x16 (&acc)[2][2], int r, int h) {
#pragma unroll
  for (int mi = 0; mi < 2; ++mi)
#pragma unroll
    for (int ni = 0; ni < 2; ++ni)
#pragma unroll
      for (int i = 0; i < 16; ++i) {
        int row = row0 + 32 * mi + (i & 3) + 8 * (i >> 2) + 4 * h;
        C[(size_t)row * ldc + col0 + 32 * ni + r] = f2bf(acc[mi][ni][i]);
      }
}
DI void store_trans(u16* __restrict__ T, size_t ldt, size_t colbase, size_t tokbase, const f32x16 (&acc)[2][2], int r, int h, u16* st) {
#pragma unroll
  for (int mi = 0; mi < 2; ++mi)
#pragma unroll
    for (int ni = 0; ni < 2; ++ni)
#pragma unroll
      for (int g = 0; g < 4; ++g) {
        uint2 o;
        o.x = pack2(acc[mi][ni][4 * g], acc[mi][ni][4 * g + 1]);
        o.y = pack2(acc[mi][ni][4 * g + 2], acc[mi][ni][4 * g + 3]);
        *(uint2*)&st[(32 * ni + r) * 72 + 32 * mi + 8 * g + 4 * h] = o;
      }
  const int lane = r + 32 * h;
#pragma unroll
  for (int j = 0; j < 8; ++j) {
    const int chunk = j * 64 + lane, ch = chunk >> 3, t8 = (chunk & 7) * 8;
    const u32x4 v = *(const u32x4*)&st[ch * 72 + t8];
    __builtin_nontemporal_store(v, (u32x4*)(T + (colbase + ch) * ldt + tokbase + t8));
  }
}
DI void rope_acc(const Epi& e, int row0, f32x16 (&acc)[2][2], int r, int h) {
  const int ib = row0 % TB;
  if (ib < 256) return;
#pragma unroll
  for (int mi = 0; mi < 2; ++mi)
#pragma unroll
    for (int i = 0; i < 16; ++i) {
      int pos = ib - 256 + 32 * mi + (i & 3) + 8 * (i >> 2) + 4 * h;
      float cs = e.cosT[pos * 32 + r], sn = e.sinT[pos * 32 + r];
      float x1 = acc[mi][0][i], x2 = acc[mi][1][i];
      acc[mi][0][i] = x1 * cs - x2 * sn;
      acc[mi][1][i] = x1 * sn + x2 * cs;
      if ((i & 3) == 3) __builtin_amdgcn_sched_barrier(0);
    }
}

DI void scale_acc(f32x16 (&acc)[2][2], float sc) {
#pragma unroll
  for (int mi = 0; mi < 2; ++mi)
#pragma unroll
    for (int ni = 0; ni < 2; ++ni)
#pragma unroll
      for (int i = 0; i < 16; ++i) acc[mi][ni][i] *= sc;
}
DI void epilogue(const Epi& e, int row0, int col0, f32x16 (&acc)[2][2], int r, int h, u16* st) {
  const int b = row0 / TB, ib = row0 % TB;
  switch (e.mode) {
    case E_PLAIN: store_plain(e.C, e.ldc, row0, col0, acc, r, h); break;
    case E_MLA_IN:
      if (col0 == 768) rope_acc(e, row0, acc, r, h);
      store_plain(e.C, e.ldc, row0, col0, acc, r, h); break;
    case E_MLA_Q:
      if ((col0 % 192) == 128) rope_acc(e, row0, acc, r, h);
      scale_acc(acc, 0.07216878364870322f * LOG2E);
      store_plain(e.C, e.ldc, row0, col0, acc, r, h); break;
    case E_MLA_KV: {
      int head = col0 >> 8, within = col0 & 255;
      if (within < 128) store_plain(e.C + head * 128 + within - col0, 1024, row0, col0, acc, r, h);
      else store_trans(e.C2, TB, (size_t)(b * 8 + head) * 128 + (within - 128), ib, acc, r, h, st);
    } break;
    case E_SWA_IN:
      if (col0 < 1280) { rope_acc(e, row0, acc, r, h); if (col0 < 1024) scale_acc(acc, 0.125f * LOG2E); store_plain(e.C, e.ldc, row0, col0, acc, r, h); }
      else if (col0 < 1536) { int kvh = (col0 - 1280) >> 6; store_trans(e.C2, TB, (size_t)(b * 4 + kvh) * 64, ib, acc, r, h, st); }
      else store_plain(e.C, e.ldc, row0, col0, acc, r, h);
      break;
    case E_TRANS: store_trans(e.C, ROWS, col0, row0, acc, r, h, st); break;
  }
}

DI void gemm_tile(const u16* __restrict__ A, int lda, const u16* __restrict__ Bt, int ldb, int N, int K,
                  int tm, int tn, const Epi& e, bool rownorm, char* smem) {
  constexpr int LS = 72;
  constexpr int STAGE = 512 * LS;
  u16* S0 = (u16*)smem;
  float* rs = (float*)(S0 + 2 * STAGE);
  const int tid = get_tid(), lane = tid & 63, w = tid >> 6, r = lane & 31, h = lane >> 5;
  const int wm = w >> 2, wn = w & 3;
  const int lr = tid >> 3, lk = (tid & 7) * 8;
  const u16* ap = A + (size_t)(tm * 256 + lr) * lda + lk;
  const u16* bp = Bt + (size_t)(tn * 256 + lr) * ldb + lk;
  const size_t a64 = (size_t)64 * lda, b64 = (size_t)64 * ldb;
  __syncthreads();
  float rss = 0.f;
  f32x16 acc[2][2][2];
#pragma unroll
  for (int hf = 0; hf < 2; ++hf)
#pragma unroll
    for (int mi = 0; mi < 2; ++mi)
#pragma unroll
      for (int ni = 0; ni < 2; ++ni) acc[hf][mi][ni] = zero16();
  u32x4 ra[4], rb[4];
#pragma unroll
  for (int i = 0; i < 4; ++i) { ra[i] = *(const u32x4*)(ap + i * a64); rb[i] = *(const u32x4*)(bp + i * b64); }
  u16* wa = S0 + lr * LS + lk;
#pragma unroll
  for (int i = 0; i < 4; ++i) { *(u32x4*)(wa + i * 64 * LS) = ra[i]; *(u32x4*)(wa + 256 * LS + i * 64 * LS) = rb[i]; }
  __syncthreads();
  const int nk = K >> 6;
  {
    const int ko = min(1, nk - 1) * 64;
#pragma unroll
    for (int i = 0; i < 4; ++i) { ra[i] = *(const u32x4*)(ap + i * a64 + ko); rb[i] = *(const u32x4*)(bp + i * b64 + ko); }
  }
  const u16* as0 = S0 + (wm * 128 + r) * LS + 8 * h;
  const u16* bs0 = S0 + 256 * LS + (wn * 64 + r) * LS + 8 * h;
#pragma unroll 1
  for (int kt = 0; kt < nk; ++kt) {
    const int cur = kt & 1;
    {
      u16* wn_ = wa + (cur ^ 1) * STAGE;
#pragma unroll
      for (int i = 0; i < 4; ++i) { *(u32x4*)(wn_ + i * 64 * LS) = ra[i]; *(u32x4*)(wn_ + 256 * LS + i * 64 * LS) = rb[i]; }
      const int ko = min(kt + 2, nk - 1) * 64;
#pragma unroll
      for (int i = 0; i < 4; ++i) { ra[i] = *(const u32x4*)(ap + i * a64 + ko); rb[i] = *(const u32x4*)(bp + i * b64 + ko); }
    }
    __builtin_amdgcn_sched_barrier(0);
    const u16* as = as0 + cur * STAGE;
    const u16* bs = bs0 + cur * STAGE;
    __builtin_amdgcn_s_setprio(1);
#pragma unroll
    for (int s = 0; s < 4; ++s) {
      bf16x8 af[4], bfr[2];
#pragma unroll
      for (int q = 0; q < 4; ++q) af[q] = *(const bf16x8*)&as[q * 32 * LS + 16 * s];
#pragma unroll
      for (int ni = 0; ni < 2; ++ni) bfr[ni] = *(const bf16x8*)&bs[ni * 32 * LS + 16 * s];
#pragma unroll
      for (int q = 0; q < 4; ++q)
#pragma unroll
        for (int ni = 0; ni < 2; ++ni) acc[q >> 1][q & 1][ni] = mfma32(af[q], bfr[ni], acc[q >> 1][q & 1][ni]);
    }
    __builtin_amdgcn_s_setprio(0);
    if (rownorm) {
      const u16* rp = S0 + cur * STAGE + (tid >> 1) * LS + (tid & 1) * 32;
#pragma unroll
      for (int q4 = 0; q4 < 4; ++q4) {
        const u32x4 v = *(const u32x4*)(rp + 8 * q4);
#pragma unroll
        for (int q = 0; q < 4; ++q) {
          const float a0 = bf2f((u16)(v[q] & 0xffff)), a1 = bf2f((u16)(v[q] >> 16));
          rss += a0 * a0 + a1 * a1;
        }
      }
    }
    __builtin_amdgcn_sched_barrier(0);
    __syncthreads();
  }
  if (rownorm) {
    rss += __shfl_xor(rss, 1);
    if ((tid & 1) == 0) rs[tid >> 1] = rsqrtf(rss / (float)K + EPS);
    __syncthreads();
  }
  const int row0 = tm * 256 + wm * 128, col0 = tn * 256 + wn * 64;
  if (col0 >= N) return;
#pragma unroll
  for (int hf = 0; hf < 2; ++hf) {
    if (rownorm) {
#pragma unroll
      for (int mi = 0; mi < 2; ++mi)
#pragma unroll
        for (int i = 0; i < 16; ++i) {
          float sc = rs[wm * 128 + 64 * hf + 32 * mi + (i & 3) + 8 * (i >> 2) + 4 * h];
          acc[hf][mi][0][i] *= sc; acc[hf][mi][1][i] *= sc;
        }
    }
    epilogue(e, row0 + 64 * hf, col0, acc[hf], r, h, S0 + w * (64 * 72));
  }
}

DI void gemm_phase(const u16* A, int lda, const u16* Bt, int ldb, int N, int K, const Epi& e, bool rownorm, char* smem) {
  const int ntn = (N + 255) / 256;
  if ((gridDim.x & 7) == 0) {
    const int x = blockIdx.x & 7, slot = blockIdx.x >> 3, per = gridDim.x >> 3, nl = (ROWS / 256 / 8) * ntn;
    for (int li = slot; li < nl; li += per) gemm_tile(A, lda, Bt, ldb, N, K, (li / ntn) * 8 + x, li % ntn, e, rownorm, smem);
  } else {
    const int ntiles = (ROWS / 256) * ntn;
    for (int t = blockIdx.x; t < ntiles; t += gridDim.x) gemm_tile(A, lda, Bt, ldb, N, K, t / ntn, t % ntn, e, rownorm, smem);
  }
}

struct AttnArgs {
  const u16* Q; const u16* P; const u16* KN; const u16* VT; u16* O; const float* sink; int with_ctx;
};

DI int perm32(int r) { return (r & ~12) | ((r & 4) << 1) | ((r & 8) >> 1); }

template <int MODE>
DI void attn_unit(const AttnArgs& a, int b, int head, int qb, bool isctx, char* smem) {
  constexpr int H = MODE == 0 ? 8 : 16, DQK = MODE == 0 ? 192 : 64, DV = MODE == 0 ? 128 : 64;
  constexpr int HKV = MODE == 0 ? 8 : 4, KS = DQK + 8, VS = 72, NS = DQK / 16, NDV = DV / 32;
  constexpr int LDQ = MODE == 0 ? 1536 : 2560, LDP = MODE == 0 ? 1856 : 2560, GOFF = MODE == 0 ? 832 : 1536;
  u16* Ks = (u16*)smem;
  u16* Vts = Ks + 64 * KS;
  const int tid = get_tid(), lane = tid & 63, w = tid >> 6, r = lane & 31, h = lane >> 5;
  const int hkv = MODE == 0 ? head : (head >> 2);
  const int qi = (isctx ? 0 : 256) + qb * 256 + w * 32 + r;
  const size_t Rq = (size_t)b * TB + qi;
  const int qpos = qb * 256 + w * 32 + r;
  bf16x8 qf[NS];
  {
    const u16* qp = a.Q + Rq * LDQ + head * DQK + 8 * h;
#pragma unroll
    for (int s = 0; s < NS; ++s) qf[s] = *(const bf16x8*)(qp + 16 * s);
  }
  float m = -1e30f, l = 0.f;
  if (MODE == 1) { m = a.sink[head] * LOG2E; l = (h == 0) ? 1.f : 0.f; }
  f32x16 oacc[NDV];
#pragma unroll
  for (int d = 0; d < NDV; ++d) oacc[d] = zero16();
  int tb_lo = 0, ntiles;
  if (isctx) ntiles = 4;
  else if (MODE == 0) ntiles = 36;
  else { tb_lo = (qb == 0) ? 2 : 0; const int tb_hi = (qb == 7) ? 5 : 9; ntiles = 4 + (tb_hi - tb_lo + 1); }
  const int pr = perm32(r);
  constexpr int NKL = MODE == 0 ? 3 : 1, NVL = DV / 64;
  u32x4 kreg[NKL], vreg[NVL];
  auto tile_kb = [=](int t) -> int {
    if (MODE == 1 && t >= 4) return 256 + qb * 256 - 128 + 64 * (tb_lo + t - 4);
    return 64 * t;
  };
  const int lrow = tid >> 3, lq = tid & 7;
  const u16* kbase = MODE == 0 ? a.KN + ((size_t)b * TB + lrow) * 1024 + head * 128 + lq * 8
                               : a.P + ((size_t)b * TB + lrow) * LDP + 1024 + hkv * 64 + lq * 8;
  const u16* krbase = a.P + ((size_t)b * TB + lrow) * LDP + 768 + lq * 8;
  const int vrow = MODE == 0 ? (tid >> 2) : (tid >> 3), vq = MODE == 0 ? (tid & 3) * 8 : (tid & 7) * 8;
  const u16* vbase = a.VT + ((size_t)(b * HKV + hkv) * DV + vrow) * TB + vq;
  u16* kdst = Ks + lrow * KS + lq * 8;
  u16* krdst = Ks + lrow * KS + 128 + lq * 8;
  u16* vdst = Vts + vrow * VS + vq;
#define ATTN_ISSUE_LOADS(T) do { \
    const int kb_ = tile_kb(T); \
    if (MODE == 0) { \
      const u16* kp_ = kbase + (size_t)kb_ * 1024; \
      const u16* rp_ = krbase + (size_t)kb_ * LDP; \
      kreg[0] = *(const u32x4*)kp_; kreg[1] = *(const u32x4*)(kp_ + 64); kreg[NKL - 1] = *(const u32x4*)rp_; \
    } else { \
      kreg[0] = *(const u32x4*)(kbase + (size_t)kb_ * LDP); \
    } \
    const u16* vp_ = vbase + kb_; \
    _Pragma("unroll") for (int i_ = 0; i_ < NVL; ++i_) vreg[i_] = *(const u32x4*)(vp_ + 32 * i_); \
  } while (0)
  constexpr int ASTAGE = 64 * KS + DV * VS;
#define ATTN_WRITE_STAGE(ST) do { \
    u16* kd_ = kdst + (ST) * ASTAGE; u16* krd_ = krdst + (ST) * ASTAGE; u16* vd_ = vdst + (ST) * ASTAGE; \
    if (MODE == 0) { *(u32x4*)kd_ = kreg[0]; *(u32x4*)(kd_ + 64) = kreg[1]; *(u32x4*)krd_ = kreg[NKL - 1]; } \
    else { *(u32x4*)kd_ = kreg[0]; } \
    _Pragma("unroll") for (int i_ = 0; i_ < NVL; ++i_) *(u32x4*)(vd_ + 32 * i_) = vreg[i_]; \
  } while (0)
  ATTN_ISSUE_LOADS(0);
  __syncthreads();
  ATTN_WRITE_STAGE(0);
  __syncthreads();
  ATTN_ISSUE_LOADS(min(1, ntiles - 1));
#pragma unroll 1
  for (int t = 0; t < ntiles; ++t) {
    const bool band = (MODE == 1 && t >= 4);
    const int kpos0 = tile_kb(t) - 256;
    const int cur = t & 1;
    ATTN_WRITE_STAGE(cur ^ 1);
    ATTN_ISSUE_LOADS(min(t + 2, ntiles - 1));
    __builtin_amdgcn_sched_barrier(0);
    bool skip = false;
    if (MODE == 1 && band) {
      int q0 = qb * 256 + w * 32;
      skip = (kpos0 + 63 < q0 - 128 || kpos0 > q0 + 31 + 128);
    }
    if (!skip) {
    const u16* Kc = Ks + cur * ASTAGE;
    const u16* Vc = Vts + cur * ASTAGE;
    f32x16 sacc[2];
    sacc[0] = zero16(); sacc[1] = zero16();
    {
      const u16* kp0 = &Kc[pr * KS + 8 * h];
      const u16* kp1 = kp0 + 32 * KS;
      bf16x8 k0 = *(const bf16x8*)kp0, k1 = *(const bf16x8*)kp1;
#pragma unroll
      for (int s = 0; s < NS; ++s) {
        bf16x8 n0 = k0, n1 = k1;
        if (s + 1 < NS) { n0 = *(const bf16x8*)(kp0 + 16 * (s + 1)); n1 = *(const bf16x8*)(kp1 + 16 * (s + 1)); }
        sacc[0] = mfma32(k0, qf[s], sacc[0]);
        sacc[1] = mfma32(k1, qf[s], sacc[1]);
        k0 = n0; k1 = n1;
      }
    }
    float mx = -1e30f;
#pragma unroll
    for (int u = 0; u < 2; ++u)
#pragma unroll
      for (int i = 0; i < 16; ++i) {
        float sv = sacc[u][i];
        if (MODE == 1 && band) {
          int kpos = kpos0 + 32 * u + (i & 7) + 8 * h + 16 * (i >> 3);
          int d = qpos - kpos;
          if (d > 128 || d < -128) sv = -1e30f;
          sacc[u][i] = sv;
        }
        mx = fmaxf(mx, sv);
      }
    mx = fmaxf(mx, __shfl_xor(mx, 32));
    if (__builtin_amdgcn_ballot_w64(mx > m + 8.f) != 0ull) {
      const float mnew = fmaxf(m, mx);
      const float alpha = __builtin_amdgcn_exp2f(m - mnew);
      m = mnew;
      l *= alpha;
#pragma unroll
      for (int d = 0; d < NDV; ++d)
#pragma unroll
        for (int i = 0; i < 16; ++i) oacc[d][i] *= alpha;
    }
    float ls = 0.f;
#pragma unroll
    for (int u = 0; u < 2; ++u)
#pragma unroll
      for (int i = 0; i < 16; ++i) { float pv = __builtin_amdgcn_exp2f(sacc[u][i] - m); sacc[u][i] = pv; ls += pv; }
    l += ls;
    bf16x8 pf[2][2];
#pragma unroll
    for (int u = 0; u < 2; ++u)
#pragma unroll
      for (int s2 = 0; s2 < 2; ++s2) {
        u32x4 t4;
        t4[0] = pack2(sacc[u][8 * s2 + 0], sacc[u][8 * s2 + 1]); t4[1] = pack2(sacc[u][8 * s2 + 2], sacc[u][8 * s2 + 3]);
        t4[2] = pack2(sacc[u][8 * s2 + 4], sacc[u][8 * s2 + 5]); t4[3] = pack2(sacc[u][8 * s2 + 6], sacc[u][8 * s2 + 7]);
        pf[u][s2] = __builtin_bit_cast(bf16x8, t4);
      }
#pragma unroll
    for (int u = 0; u < 2; ++u)
#pragma unroll
      for (int s2 = 0; s2 < 2; ++s2) {
        bf16x8 vf[NDV];
#pragma unroll
        for (int d = 0; d < NDV; ++d) vf[d] = *(const bf16x8*)&Vc[(d * 32 + r) * VS + 32 * u + 16 * s2 + 8 * h];
#pragma unroll
        for (int d = 0; d < NDV; ++d) oacc[d] = mfma32(vf[d], pf[u][s2], oacc[d]);
      }
    }
    __syncthreads();
  }
  l += __shfl_xor(l, 32);
  const float linv = 1.f / l;
  {
    constexpr int SW = DV + 8;
    u16* st = (u16*)smem + w * (32 * SW);
#pragma unroll
    for (int d = 0; d < NDV; ++d)
#pragma unroll
      for (int g = 0; g < 4; ++g) {
        uint2 o;
        o.x = pack2(oacc[d][4 * g] * linv, oacc[d][4 * g + 1] * linv);
        o.y = pack2(oacc[d][4 * g + 2] * linv, oacc[d][4 * g + 3] * linv);
        *(uint2*)&st[r * SW + d * 32 + 8 * g + 4 * h] = o;
      }
    const size_t Rw = (size_t)b * TB + (isctx ? 0 : 256) + qb * 256 + w * 32;
#pragma unroll
    for (int j = 0; j < DV / 16; ++j) {
      const int chunk = j * 64 + lane, qq = chunk / (DV / 8), c8 = (chunk % (DV / 8)) * 8;
      const u32x4 ov = *(const u32x4*)&st[qq * SW + c8];
      const u32x4 gv = *(const u32x4*)(a.P + (Rw + qq) * LDP + GOFF + head * DV + c8);
      u32x4 rv;
#pragma unroll
      for (int q = 0; q < 4; ++q) {
        const float o0 = bf2f((u16)(ov[q] & 0xffff)), o1 = bf2f((u16)(ov[q] >> 16));
        const float g0 = bf2f((u16)(gv[q] & 0xffff)), g1 = bf2f((u16)(gv[q] >> 16));
        rv[q] = pack2(o0 * siluf(g0), o1 * siluf(g1));
      }
      __builtin_nontemporal_store(rv, (u32x4*)(a.O + (Rw + qq) * 1024 + head * DV + c8));
    }
  }
}

template <int MODE>
DI void attn_phase(const AttnArgs& a, char* smem) {
  constexpr int H = MODE == 0 ? 8 : 16;
  const int NL = NB * H * 8;
  if (gridDim.x == 256) {
    const int x = blockIdx.x & 7, slot = blockIdx.x >> 3;
    const int grp = slot >> 3, qb = slot & 7;
    if (MODE == 0) {
      for (int it = 0; it < 8; ++it) { const int pair = (it * 4 + grp) * 8 + x; attn_unit<MODE>(a, pair >> 3, pair & 7, qb, false, smem); }
    } else {
      for (int it = 0; it < 16; ++it) { const int pair = it * 8 + x; attn_unit<MODE>(a, pair >> 2, (pair & 3) * 4 + grp, qb, false, smem); }
    }
  } else {
    for (int u = blockIdx.x; u < NL; u += gridDim.x) attn_unit<MODE>(a, u / (H * 8), (u >> 3) % H, u & 7, false, smem);
  }
  if (a.with_ctx) {
    const int NC = NB * H;
    for (int u = blockIdx.x; u < NC; u += gridDim.x) attn_unit<MODE>(a, u / H, u % H, 0, true, smem);
  }
}

DI void shortconv_phase(const Params& p, u16* PT) {
  const int tid0 = get_tid(); const int lane = tid0 & 63, w = tid0 >> 6;
  const int nitems = 3072 * NB * 2;
  for (int it = blockIdx.x * NW + w; it < nitems; it += gridDim.x * NW) {
    const int ch = it / (NB * 2), rem = it % (NB * 2), b = rem >> 1, isctx = rem & 1;
    const float w0 = p.c_conv_w[ch], w1 = p.c_conv_w[3072 + ch], w2 = p.c_conv_w[6144 + ch], cb = p.c_conv_b[ch];
    u16* base = PT + (size_t)ch * ROWS + (size_t)b * TB + (isctx ? 0 : 256);
    if (!isctx) {
      u32x4 q[4];
#pragma unroll
      for (int k = 0; k < 4; ++k) q[k] = *(const u32x4*)(base + (k * 64 + lane) * 8);
      float first[4], last[4];
#pragma unroll
      for (int k = 0; k < 4; ++k) { first[k] = bf2f((u16)(q[k][0] & 0xffff)); last[k] = bf2f((u16)(q[k][3] >> 16)); }
#pragma unroll
      for (int k = 0; k < 4; ++k) {
        float v[10];
#pragma unroll
        for (int e = 0; e < 4; ++e) { v[1 + 2 * e] = bf2f((u16)(q[k][e] & 0xffff)); v[2 + 2 * e] = bf2f((u16)(q[k][e] >> 16)); }
        const float lsame = __shfl_up(last[k], 1), rsame = __shfl_down(first[k], 1);
        const float lprev = (k > 0) ? __shfl(last[k > 0 ? k - 1 : 0], 63) : 0.f;
        const float rnext = (k < 3) ? __shfl(first[k < 3 ? k + 1 : 3], 0) : 0.f;
        v[0] = lane == 0 ? lprev : lsame;
        v[9] = lane == 63 ? rnext : rsame;
        u32x4 o;
#pragma unroll
        for (int e = 0; e < 4; ++e) {
          const int s2 = 2 * e;
          const float y0 = cb + w0 * v[s2] + w1 * v[s2 + 1] + w2 * v[s2 + 2];
          const float y1 = cb + w0 * v[s2 + 1] + w1 * v[s2 + 2] + w2 * v[s2 + 3];
          o[e] = pack2(y0, y1);
        }
        *(u32x4*)(base + (k * 64 + lane) * 8) = o;
      }
    } else {
      float v[6];
      uint2 q = *(const uint2*)(base + lane * 4);
      v[1] = bf2f((u16)(q.x & 0xffff)); v[2] = bf2f((u16)(q.x >> 16)); v[3] = bf2f((u16)(q.y & 0xffff)); v[4] = bf2f((u16)(q.y >> 16));
      float lft = __shfl_up(v[4], 1), rgt = __shfl_down(v[1], 1);
      v[0] = lane == 0 ? 0.f : lft;
      v[5] = lane == 63 ? 0.f : rgt;
      uint2 o;
      o.x = pack2(cb + w0 * v[0] + w1 * v[1] + w2 * v[2], cb + w0 * v[1] + w1 * v[2] + w2 * v[3]);
      o.y = pack2(cb + w0 * v[2] + w1 * v[3] + w2 * v[4], cb + w0 * v[3] + w1 * v[4] + w2 * v[5]);
      *(uint2*)(base + lane * 4) = o;
    }
  }
}

template <int MT>
DI void conv_unit(const u16* __restrict__ usrc, const u16* __restrict__ gsrc, const u16* __restrict__ gatesrc,
                  u16* __restrict__ dst, const float* __restrict__ hf, const float* __restrict__ hb, float bias,
                  int n, int tok0, int t_lo, char* smem) {
  constexpr int MROWS = MT * 256;
  const int FL = n + MROWS, FLP = FL + 16;
  const int OFF = t_lo + MROWS;
  u16* fc = (u16*)smem;
  u16* Us = fc + 8 * 3088;
  const int tid = get_tid(), lane = tid & 63, w = tid >> 6, r = lane & 31, h = lane >> 5;
  __syncthreads();
  {
    const int FL8 = FL >> 3;
    for (int idx = tid; idx < 8 * FL8; idx += NT) {
      const int sg = idx / FL8, p8 = (idx - sg * FL8) * 8;
      const int lag0 = sg + OFF - p8;
      float v[8];
#pragma unroll
      for (int j = 0; j < 8; ++j) {
        const int lag = lag0 - j;
        float x = 0.f;
        if (lag > 0) { if (lag < n) x = hf[lag]; }
        else if (lag < 0) { if (lag > -n) x = hb[-lag]; }
        else x = hf[0] + hb[0];
        v[j] = x;
      }
      u32x4 o; o[0] = pack2(v[0], v[1]); o[1] = pack2(v[2], v[3]); o[2] = pack2(v[4], v[5]); o[3] = pack2(v[6], v[7]);
      *(u32x4*)&fc[sg * FLP + p8] = o;
    }
  }
  f32x16 acc[MT];
#pragma unroll
  for (int mi = 0; mi < MT; ++mi) acc[mi] = zero16();
  const int nchunks = n / 256;
  const int abase = (r & 7) * FLP + 8 * h - 8 * (r >> 3) + OFF;
  const int ub = tid >> 4, usc = (tid & 15) * 8;
  const u16* up = usrc + (size_t)ub * TB + tok0 + usc;
  u16* ud = Us + ub * 264 + usc;
  u32x4 ureg[2];
#pragma unroll
  for (int i = 0; i < 2; ++i) ureg[i] = *(const u32x4*)(up + 128 * i);
  constexpr int USTAGE = 32 * 264;
  __syncthreads();
#pragma unroll
  for (int i = 0; i < 2; ++i) *(u32x4*)(ud + 128 * i) = ureg[i];
  __syncthreads();
  {
    const int nc = min(1, nchunks - 1);
#pragma unroll
    for (int i = 0; i < 2; ++i) ureg[i] = *(const u32x4*)(up + nc * 256 + 128 * i);
  }
#pragma unroll 1
  for (int ch = 0; ch < nchunks; ++ch) {
    const int cur = ch & 1;
#pragma unroll
    for (int i = 0; i < 2; ++i) *(u32x4*)(ud + (cur ^ 1) * USTAGE + 128 * i) = ureg[i];
    {
      const int nc = min(ch + 2, nchunks - 1);
#pragma unroll
      for (int i = 0; i < 2; ++i) ureg[i] = *(const u32x4*)(up + nc * 256 + 128 * i);
    }
    __builtin_amdgcn_sched_barrier(0);
    {
      const u16* bp_ = &Us[cur * USTAGE + r * 264 + 8 * h];
      const u16* ap_ = &fc[abase + ch * 256 - t_lo - w * MT * 32];
      bf16x8 bcur = *(const bf16x8*)bp_, acur[MT];
#pragma unroll
      for (int mi = 0; mi < MT; ++mi) acur[mi] = *(const bf16x8*)(ap_ - mi * 32);
#pragma unroll 4
      for (int kbl = 0; kbl < 16; ++kbl) {
        const int kn = min(kbl + 1, 15);
        bf16x8 bnxt = *(const bf16x8*)(bp_ + 16 * kn), anxt[MT];
#pragma unroll
        for (int mi = 0; mi < MT; ++mi) anxt[mi] = *(const bf16x8*)(ap_ + 16 * kn - mi * 32);
#pragma unroll
        for (int mi = 0; mi < MT; ++mi) acc[mi] = mfma32(acur[mi], bcur, acc[mi]);
        bcur = bnxt;
#pragma unroll
        for (int mi = 0; mi < MT; ++mi) acur[mi] = anxt[mi];
      }
    }
    __builtin_amdgcn_sched_barrier(0);
    __syncthreads();
  }
  {
    constexpr int SW = MT * 32 + 8;
    u16* st = (u16*)smem + w * (32 * SW);
#pragma unroll
    for (int mi = 0; mi < MT; ++mi)
#pragma unroll
      for (int g = 0; g < 4; ++g) {
        uint2 o;
        o.x = pack2(acc[mi][4 * g], acc[mi][4 * g + 1]);
        o.y = pack2(acc[mi][4 * g + 2], acc[mi][4 * g + 3]);
        *(uint2*)&st[r * SW + mi * 32 + 8 * g + 4 * h] = o;
      }
    const int tw = t_lo + w * MT * 32;
#pragma unroll
    for (int j = 0; j < MT * 2; ++j) {
      const int chunk = j * 64 + lane, bb = chunk / (MT * 4), t8 = (chunk % (MT * 4)) * 8;
      const u32x4 yv = *(const u32x4*)&st[bb * SW + t8];
      const size_t off = (size_t)bb * TB + tok0 + tw + t8;
      const u32x4 uv = *(const u32x4*)(usrc + off), gv = *(const u32x4*)(gsrc + off);
      u32x4 tv = uv;
      if (gatesrc) tv = *(const u32x4*)(gatesrc + off);
      u32x4 ov;
#pragma unroll
      for (int q = 0; q < 4; ++q) {
        const float y0 = bf2f((u16)(yv[q] & 0xffff)), y1 = bf2f((u16)(yv[q] >> 16));
        const float u0 = bf2f((u16)(uv[q] & 0xffff)), u1 = bf2f((u16)(uv[q] >> 16));
        const float g0 = bf2f((u16)(gv[q] & 0xffff)), g1 = bf2f((u16)(gv[q] >> 16));
        float z0 = g0 * (y0 + u0 * bias), z1 = g1 * (y1 + u1 * bias);
        if (gatesrc) { z0 *= siluf(bf2f((u16)(tv[q] & 0xffff))); z1 *= siluf(bf2f((u16)(tv[q] >> 16))); }
        ov[q] = pack2(z0, z1);
      }
      __builtin_nontemporal_store(ov, (u32x4*)(dst + off));
    }
  }
}

DI void conv_phase(const Params& p, int o, const u16* PT, const u16* Uin, u16* dstT, char* smem) {
  const int nunits = 2048 + 1024;
  for (int u0 = blockIdx.x; u0 < nunits; u0 += gridDim.x) {
    int u = u0;
    if ((gridDim.x & 7) == 0 && u0 < 2048) {
      const int x = u0 & 7, li = u0 >> 3;
      u = (((li >> 1) * 8 + x) << 1) | (li & 1);
    }
    const bool isctx = u >= 2048;
    const int c = isctx ? (u - 2048) : (u >> 1);
    const u16* usrc = Uin + (size_t)c * ROWS;
    const u16* gsrc = PT + (size_t)(1024 * (1 + o) + c) * ROWS;
    const u16* gatesrc = o == 1 ? PT + (size_t)(3072 + c) * ROWS : nullptr;
    u16* dst = dstT + (size_t)c * ROWS;
    const float bias = p.c_filt_bias[o * 1024 + c];
    if (!isctx) {
      const float* hf = p.filt + (size_t)((0 * 2 + o) * 1024 + c) * 2048;
      const float* hb = p.filt + (size_t)((1 * 2 + o) * 1024 + c) * 2048;
      conv_unit<4>(usrc, gsrc, gatesrc, dst, hf, hb, bias, 2048, 256, (u & 1) * 1024, smem);
    } else {
      const float* fb = p.filt + (size_t)4096 * 2048;
      const float* hf = fb + (size_t)((0 * 2 + o) * 1024 + c) * 256;
      const float* hb = fb + (size_t)((1 * 2 + o) * 1024 + c) * 256;
      conv_unit<1>(usrc, gsrc, gatesrc, dst, hf, hb, bias, 256, 0, 0, smem);
    }
  }
}

DI void transpose_phase(const u16* __restrict__ src, u16* __restrict__ dst, char* smem) {
  u16* tl = (u16*)smem;
  const int tid = get_tid();
  const int ntiles = 16 * (ROWS / 64);
  for (int t = blockIdx.x; t < ntiles; t += gridDim.x) {
    const int tc = t & 15, tr = t >> 4, c0 = tc * 64, r0 = tr * 64;
    __syncthreads();
    {
      int cidx = tid, cl = cidx >> 3, q = (cidx & 7) * 8;
      uint4 v = *(const uint4*)(src + (size_t)(c0 + cl) * ROWS + r0 + q);
      unsigned* d = (unsigned*)&tl[cl * 66 + q];
      d[0] = v.x; d[1] = v.y; d[2] = v.z; d[3] = v.w;
    }
    __syncthreads();
    {
      int cidx = tid, tk = cidx >> 3, q = (cidx & 7) * 8;
      unsigned o[4];
#pragma unroll
      for (int e = 0; e < 4; ++e) o[e] = (unsigned)tl[(q + 2 * e) * 66 + tk] | ((unsigned)tl[(q + 2 * e + 1) * 66 + tk] << 16);
      uint4 v; v.x = o[0]; v.y = o[1]; v.z = o[2]; v.w = o[3];
      *(uint4*)(dst + (size_t)(r0 + tk) * 1024 + c0 + q) = v;
    }
  }
}

DI void mla_layer(const Params& p, const XcdBarrier& xb, int j, bool with_ctx, char* smem) {
  u16* P = p.BIG;
  u16* Q = P + (size_t)ROWS * 1856;
  u16* KN = Q + (size_t)ROWS * 1536;
  u16* VT = KN + (size_t)ROWS * 1024;
  Epi e{}; e.cosT = p.cosT; e.sinT = p.sinT;
  e.mode = E_MLA_IN; e.C = P; e.ldc = 1856;
  gemm_phase(p.R0, 1024, p.aWin + (size_t)j * 1856 * 1024, 1024, 1856, 1024, e, false, smem);
  xcd_barrier(xb);
  e.mode = E_MLA_Q; e.C = Q; e.ldc = 1536;
  gemm_phase(P, 1856, p.aWq + (size_t)j * 1536 * 512, 512, 1536, 512, e, true, smem);
  e.mode = E_MLA_KV; e.C = KN; e.ldc = 1024; e.C2 = VT;
  gemm_phase(P + 512, 1856, p.aWkv + (size_t)j * 2048 * 256, 256, 2048, 256, e, true, smem);
  xcd_barrier(xb);
  AttnArgs a{}; a.Q = Q; a.P = P; a.KN = KN; a.VT = VT; a.O = p.R0; a.sink = nullptr; a.with_ctx = with_ctx ? 1 : 0;
  attn_phase<0>(a, smem);
  xcd_barrier(xb);
  e.mode = E_PLAIN; e.C = Q; e.ldc = 1024;
  gemm_phase(p.R0, 1024, p.aWout + (size_t)j * 1024 * 1024, 1024, 1024, 1024, e, false, smem);
  xcd_barrier(xb);
}

__global__ void __launch_bounds__(512, 2) mega(Params p) {
  extern __shared__ __attribute__((aligned(16))) char smem[];
  __shared__ uint4 xb_words;
  if (threadIdx.x == 0) xb_words = make_uint4(0u, 0u, 0u, 0u);
  __syncthreads();
  const XcdBarrier xb = xcd_barrier_post(p.bar, (volatile LAS unsigned*)&xb_words);
  if (p.out == nullptr) cg::this_grid().sync();
  {
    const int NMOD = 192, NTR = 4256, NROPE = 128, NF1 = 288;
    const int nitems = NMOD + NTR + NROPE + NF1;
    for (int it = blockIdx.x; it < nitems; it += gridDim.x) {
      if (it < NMOD) mod_item(p, it, (float*)smem);
      else if (it < NMOD + NTR) {
        int t = it - NMOD;
        float* sm = (float*)smem;
        if (t < 928) { int j = t / 464; transpose_tile(p.a_w_in + (size_t)j * 1024 * 1856, p.aWin + (size_t)j * 1856 * 1024, 1024, 1856, nullptr, t % 464, sm); }
        else if ((t -= 928) < 384) { int j = t / 192; transpose_tile(p.a_w_q + (size_t)j * 512 * 1536, p.aWq + (size_t)j * 1536 * 512, 512, 1536, p.a_g_q + j * 512, t % 192, sm); }
        else if ((t -= 384) < 256) { int j = t / 128; transpose_tile(p.a_w_kv + (size_t)j * 256 * 2048, p.aWkv + (size_t)j * 2048 * 256, 256, 2048, p.a_g_kv + j * 256, t % 128, sm); }
        else if ((t -= 256) < 512) { int j = t / 256; transpose_tile(p.a_w_out + (size_t)j * 1024 * 1024, p.aWout + (size_t)j * 1024 * 1024, 1024, 1024, nullptr, t % 256, sm); }
        else if ((t -= 512) < 640) transpose_tile(p.b_w_in, p.bWin, 1024, 2560, nullptr, t, sm);
        else if ((t -= 640) < 256) transpose_tile(p.b_w_out, p.bWout, 1024, 1024, nullptr, t, sm);
        else if ((t -= 256) < 1024) transpose_tile(p.c_w_in, p.cWin, 1024, 4096, nullptr, t, sm);
        else { t -= 1024; transpose_tile(p.c_w_out, p.cWout, 1024, 1024, nullptr, t, sm); }
      }
      else if (it < NMOD + NTR + NROPE) rope_item(p, it - NMOD - NTR);
      else f1_item(p, it - NMOD - NTR - NROPE);
    }
  }
  xcd_barrier(xb);
  rowwise_phase(p, 0, nullptr);
  for (int it = blockIdx.x; it < 2048 * 9; it += gridDim.x) f2_item(p, it);
  xcd_barrier(xb);
  mla_layer(p, xb, 0, true, smem);
  rowwise_phase(p, 1, p.BIG + (size_t)ROWS * 1856);
  xcd_barrier(xb);
  {
    u16* P = p.BIG;
    u16* VT = P + (size_t)ROWS * 2560;
    u16* Y = VT + (size_t)NB * 4 * 64 * TB;
    Epi e{}; e.cosT = p.cosT; e.sinT = p.sinT;
    e.mode = E_SWA_IN; e.C = P; e.ldc = 2560; e.C2 = VT;
    gemm_phase(p.R0, 1024, p.bWin, 1024, 2560, 1024, e, false, smem);
    xcd_barrier(xb);
    AttnArgs a{}; a.Q = P; a.P = P; a.KN = nullptr; a.VT = VT; a.O = p.R0; a.sink = p.b_sink; a.with_ctx = 1;
    attn_phase<1>(a, smem);
    xcd_barrier(xb);
    e.mode = E_PLAIN; e.C = Y; e.ldc = 1024;
    gemm_phase(p.R0, 1024, p.bWout, 1024, 1024, 1024, e, false, smem);
    xcd_barrier(xb);
    rowwise_phase(p, 2, Y);
    xcd_barrier(xb);
  }
  {
    u16* PT = p.BIG;
    u16* Z = PT + (size_t)4096 * ROWS;
    Epi e{}; e.mode = E_TRANS; e.C = PT;
    gemm_phase(p.R0, 1024, p.cWin, 1024, 4096, 1024, e, false, smem);
    xcd_barrier(xb);
    shortconv_phase(p, PT);
    xcd_barrier(xb);
    conv_phase(p, 0, PT, PT, Z, smem);
    xcd_barrier(xb);
    conv_phase(p, 1, PT, Z, p.R0, smem);
    xcd_barrier(xb);
    transpose_phase(p.R0, Z, smem);
    xcd_barrier(xb);
    e.mode = E_PLAIN; e.C = p.R0; e.ldc = 1024;
    gemm_phase(Z, 1024, p.cWout, 1024, 1024, 1024, e, false, smem);
    xcd_barrier(xb);
    rowwise_phase(p, 3, p.R0);
    xcd_barrier(xb);
  }
  mla_layer(p, xb, 1, false, smem);
  rowwise_phase(p, 4, p.BIG + (size_t)ROWS * 1856);
}

extern "C" void kernel_launch(void* const* d_in, const int* in_sizes, int n_in,
                              void* d_out, int out_size, void* d_ws, size_t ws_size,
                              hipStream_t stream) {
  static int grid_blocks = 0;
  if (!grid_blocks) {
    int dev = 0, cus = 0, per_cu = 0;
    (void)hipGetDevice(&dev);
    (void)hipDeviceGetAttribute(&cus, hipDeviceAttributeMultiprocessorCount, dev);
    (void)hipFuncSetAttribute((const void*)mega, hipFuncAttributeMaxDynamicSharedMemorySize, SMEM_BYTES);
    (void)hipOccupancyMaxActiveBlocksPerMultiprocessor(&per_cu, mega, NT, SMEM_BYTES);
    if (per_cu > 1) per_cu = 1;
    if (per_cu < 1) per_cu = 1;
    grid_blocks = cus * per_cu;
  }
  Params p{};
  const float* const* in = (const float* const*)d_in;
  p.x = in[0]; p.c = in[1]; p.ctx = in[2]; p.c_ctx = in[3]; p.w_mod = in[4]; p.b_mod = in[5]; p.g_pre = in[6]; p.g_post = in[7];
  p.a_w_in = in[8]; p.a_g_q = in[9]; p.a_w_q = in[10]; p.a_g_kv = in[11]; p.a_w_kv = in[12]; p.a_w_out = in[13];
  p.b_w_in = in[14]; p.b_sink = in[15]; p.b_w_out = in[16];
  p.c_w_in = in[17]; p.c_conv_w = in[18]; p.c_conv_b = in[19]; p.c_f_w1 = in[20]; p.c_f_b1 = in[21]; p.c_f_freq = in[22];
  p.c_f_w2 = in[23]; p.c_f_b2 = in[24]; p.c_f_w3 = in[25]; p.c_filt_bias = in[26]; p.c_w_out = in[27];
  p.out = (float*)d_out;
  char* ws = (char*)d_ws;
  size_t off = 0;
  auto take = [&](size_t bytes) { char* q = ws + off; off += (bytes + 255) & ~(size_t)255; return q; };
  p.aWin = (u16*)take((size_t)2 * 1856 * 1024 * 2);
  p.aWq = (u16*)take((size_t)2 * 1536 * 512 * 2);
  p.aWkv = (u16*)take((size_t)2 * 2048 * 256 * 2);
  p.aWout = (u16*)take((size_t)2 * 1024 * 1024 * 2);
  p.bWin = (u16*)take((size_t)2560 * 1024 * 2);
  p.bWout = (u16*)take((size_t)1024 * 1024 * 2);
  p.cWin = (u16*)take((size_t)4096 * 1024 * 2);
  p.cWout = (u16*)take((size_t)1024 * 1024 * 2);
  p.mod = (float*)take((size_t)4 * 33 * 3072 * 4);
  p.cosT = (float*)take((size_t)2048 * 32 * 4);
  p.sinT = (float*)take((size_t)2048 * 32 * 4);
  p.h2 = (float*)take((size_t)2304 * 64 * 4);
  p.filt = (float*)take((size_t)2304 * 4096 * 4);
  p.ctxw = (float*)take((size_t)NB * 256 * 1024 * 4);
  p.R0 = (u16*)take((size_t)ROWS * 1024 * 2);
  p.BIG = (u16*)take((size_t)ROWS * (1856 + 1536 + 1024 + 1024) * 2);
  p.bar = (unsigned*)take((size_t)XCD_BAR_WORDS * 4);
  if (off > ws_size) { fprintf(stderr, "workspace too small: need %zu have %zu\n", off, ws_size); return; }
  (void)hipMemsetAsync(p.bar, 0, (size_t)XCD_BAR_WORDS * 4, stream);
  void* args[] = {&p};
  hipError_t e = hipLaunchCooperativeKernel((void*)mega, dim3(grid_blocks), dim3(NT), args, SMEM_BYTES, stream);
  if (e != hipSuccess) fprintf(stderr, "coop launch failed: %s (grid %d)\n", hipGetErrorString(e), grid_blocks);
}
```
